# Optimizing an MI355X kernel written in HIP

```python
import jax, jax.numpy as jnp
from jax import lax
import numpy as np

D_MODEL = 1024
BATCH = 16
SEQ = 2048
DEPTH = 1

GRID_W = 64
CTX_LEN = 256
ATT_HEADS = 8
ATT_KV_HEADS = 2
ATT_GROUP = ATT_HEADS // ATT_KV_HEADS
ATT_HEAD_DIM = 64
ATT_WIDTH = ATT_HEADS * ATT_HEAD_DIM
ATT_KV_WIDTH = ATT_KV_HEADS * ATT_HEAD_DIM
WINDOW = 128
BLOCK = 128
ROPE_BASE = 10000.0
HG_WIDTH = D_MODEL // 2
HG_EXPAND = 128
HG_HEADS = HG_WIDTH // HG_EXPAND
CHUNK = 64
D_FF = 2816
N_MOD = 9
IN_WIDTH = ATT_WIDTH + 2 * ATT_KV_WIDTH + 5 * HG_WIDTH + 2 * D_MODEL
EPS = 1e-6
NEG_INF = -1e30

kernel_name = 'hybrid_dit_gqa_hgrn2_macaron'


def rmsnorm(x, g):
    x32 = x.astype(jnp.float32)
    y = x32 * lax.rsqrt(jnp.mean(x32 * x32, axis=-1, keepdims=True) + EPS)
    return (y * g.astype(jnp.float32)).astype(x.dtype)


def swiglu(h, w_in, w_out):
    gate, up = jnp.split(h @ w_in, 2, axis=-1)
    return (jax.nn.silu(gate) * up) @ w_out


def ada_pre(z, g, shift, scale):
    return rmsnorm(z, g) * (1 + scale) + shift


def ada_post(z, y, g, gate, w):
    return z + w * gate * rmsnorm(y, g)


def rope_1d(x, pos):
    half = x.shape[-1] // 2
    freqs = ROPE_BASE ** (-jnp.arange(half, dtype=jnp.float32) / half)
    ang = pos.astype(jnp.float32)[:, None] * freqs[None, :]
    cos, sin = jnp.cos(ang).astype(x.dtype), jnp.sin(ang).astype(x.dtype)
    x1, x2 = x[..., :half], x[..., half:]
    return jnp.concatenate([x1 * cos - x2 * sin, x1 * sin + x2 * cos], axis=-1)


def rope_2d(x, row, col):
    h = x.shape[-1] // 2
    return jnp.concatenate([rope_1d(x[..., :h], row), rope_1d(x[..., h:], col)], axis=-1)


def split_in(p):
    sizes = (ATT_WIDTH, ATT_KV_WIDTH, ATT_KV_WIDTH, HG_WIDTH, HG_WIDTH, HG_WIDTH, HG_WIDTH, HG_WIDTH, D_MODEL, D_MODEL)
    points = [int(v) for v in np.cumsum(sizes)[:-1]]
    return jnp.split(p, points, axis=-1)


def q_heads(z):
    B, T, _ = z.shape
    return z.reshape(B, T, ATT_KV_HEADS, ATT_GROUP, ATT_HEAD_DIM).transpose(0, 2, 3, 1, 4)


def kv_heads(z):
    B, T, _ = z.shape
    return z.reshape(B, T, ATT_KV_HEADS, ATT_HEAD_DIM).transpose(0, 2, 1, 3)


def hg_heads(z):
    B, T, _ = z.shape
    return z.reshape(B, T, HG_HEADS, HG_EXPAND).transpose(0, 2, 1, 3)


def hg_merge(o):
    B, H, T, d = o.shape
    return o.transpose(0, 2, 1, 3).reshape(B, T, H * d)


def softmax_with_sink(logits, sink):
    sink_col = jnp.broadcast_to(sink, logits.shape[:-1] + (1,))
    p = jax.nn.softmax(jnp.concatenate([logits, sink_col], axis=-1), axis=-1)
    return p[..., :-1]


def window_attention(q, k, v, kc, vc, sink):
    B, KVH, G, T, hd = q.shape
    nb = T // BLOCK
    scale = hd ** -0.5
    qb = q.reshape(B, KVH, G, nb, BLOCK, hd)

    def band(z):
        zp = jnp.pad(z, ((0, 0), (0, 0), (BLOCK, BLOCK), (0, 0))).reshape(B, KVH, nb + 2, BLOCK, hd)
        return jnp.concatenate([zp[:, :, :nb], zp[:, :, 1:nb + 1], zp[:, :, 2:]], axis=3)

    kb, vb = band(k), band(v)
    blk = jnp.arange(nb)[:, None, None] * BLOCK
    qpos = blk + jnp.arange(BLOCK)[None, :, None]
    kpos = blk - BLOCK + jnp.arange(3 * BLOCK)[None, None, :]
    valid = (jnp.abs(kpos - qpos) <= WINDOW) & (kpos >= 0) & (kpos < T)
    s_band = jnp.einsum('bkgnqd,bknsd->bkgnqs', qb, kb).astype(jnp.float32) * scale
    s_band = jnp.where(valid, s_band, NEG_INF)
    s_ctx = jnp.einsum('bkgnqd,bksd->bkgnqs', qb, kc).astype(jnp.float32) * scale
    sink_b = sink.astype(jnp.float32).reshape(KVH, G)[None, :, :, None, None, None]
    p = softmax_with_sink(jnp.concatenate([s_band, s_ctx], axis=-1), sink_b).astype(v.dtype)
    o = (jnp.einsum('bkgnqs,bknsd->bkgnqd', p[..., :3 * BLOCK], vb)
         + jnp.einsum('bkgnqs,bksd->bkgnqd', p[..., 3 * BLOCK:], vc))
    return o.reshape(B, KVH, G, T, hd).transpose(0, 3, 1, 2, 4).reshape(B, T, KVH * G * hd)


def context_attention(qc, kc, vc, sink):
    B, KVH, G, L, hd = qc.shape
    s = jnp.einsum('bkgqd,bksd->bkgqs', qc, kc).astype(jnp.float32) * (hd ** -0.5)
    sink_b = sink.astype(jnp.float32).reshape(KVH, G)[None, :, :, None, None]
    p = softmax_with_sink(s, sink_b).astype(vc.dtype)
    o = jnp.einsum('bkgqs,bksd->bkgqd', p, vc)
    return o.transpose(0, 3, 1, 2, 4).reshape(B, L, KVH * G * hd)


def gated_scan(q, k, v, logf, s0):
    B, H, T, dk = q.shape
    dv = v.shape[-1]
    n = T // CHUNK

    def chunks(z):
        return jnp.moveaxis(z.reshape(B, H, n, CHUNK, z.shape[-1]), 2, 0)

    tril = jnp.tril(jnp.ones((CHUNK, CHUNK), dtype=bool))

    def step(S, inp):
        qc, kc, vc, lf = inp
        b = jnp.cumsum(lf, axis=-2)
        o_inter = jnp.einsum('bhtd,bhde->bhte', qc * jnp.exp(b), S)
        diff = b[:, :, :, None, :] - b[:, :, None, :, :]
        decay = jnp.where(tril[:, :, None], jnp.exp(jnp.minimum(diff, 0.0)), 0.0)
        scores = jnp.einsum('bhtsd,bhsd->bhts', qc[:, :, :, None, :] * decay, kc)
        o_intra = jnp.einsum('bhts,bhse->bhte', scores, vc)
        b_last = b[:, :, -1:, :]
        k_dec = kc * jnp.exp(b_last - b)
        S_new = jnp.exp(b_last[:, :, 0, :])[..., None] * S + jnp.einsum('bhsd,bhse->bhde', k_dec, vc)
        return S_new, o_inter + o_intra

    S_fin, o = lax.scan(step, s0, (chunks(q), chunks(k), chunks(v), chunks(logf)))
    return jnp.moveaxis(o, 0, 2).reshape(B, H, T, dv), S_fin


def hgrn_bidir(q, v, lf_f, k_f, lf_b, k_b, s0_f, s0_b):
    flip = lambda z: jnp.flip(z, axis=2)
    o_f, s_f = gated_scan(q, k_f, v, lf_f, s0_f)
    o_b, s_b = gated_scan(flip(q), flip(k_b), flip(v), flip(lf_b), s0_b)
    return o_f + flip(o_b), s_f, s_b


def hg_forget(z, lb):
    f = lb + (1.0 - lb) * jax.nn.sigmoid(z.astype(jnp.float32))
    return hg_heads(jnp.log(f)), hg_heads(1.0 - f)


def mixer(h, hc, w_in, sink, lb_f, lb_b, g_hnorm, w_o_attn, w_o_hgrn, w_out, need_ctx):
    B, T, _ = h.shape
    rows = T // GRID_W
    row = jnp.repeat(jnp.arange(rows, dtype=jnp.int32), GRID_W)
    col = jnp.tile(jnp.arange(GRID_W, dtype=jnp.int32), rows)
    f32 = jnp.float32
    aq, ak, av, hq, hff, hfb, hi, hg, ga, gh = split_in(h @ w_in)
    aqc, akc, avc, hqc, hffc, hfbc, hic, hgc, gac, ghc = split_in(hc @ w_in)
    q = rope_2d(q_heads(aq), row, col)
    k = rope_2d(kv_heads(ak), row, col)
    kc, vc = kv_heads(akc), kv_heads(avc)
    o_att = window_attention(q, k, kv_heads(av), kc, vc, sink)
    qhc = hg_heads(jax.nn.silu(hqc.astype(f32)))
    vhc = hg_heads(hic.astype(f32))
    lfc_f, kc_f = hg_forget(hffc, lb_f)
    lfc_b, kc_b = hg_forget(hfbc, lb_b)
    s0 = jnp.zeros((B, HG_HEADS, HG_EXPAND, HG_EXPAND), f32)
    o_hc, s_f, s_b = hgrn_bidir(qhc, vhc, lfc_f, kc_f, lfc_b, kc_b, s0, s0)
    qh = hg_heads(jax.nn.silu(hq.astype(f32)))
    vh = hg_heads(hi.astype(f32))
    lf_f, k_f = hg_forget(hff, lb_f)
    lf_b, k_b = hg_forget(hfb, lb_b)
    o_h, _, _ = hgrn_bidir(qh, vh, lf_f, k_f, lf_b, k_b, s_f, s_b)

    def readout(o, gate):
        return rmsnorm(hg_merge(o), g_hnorm).astype(gate.dtype) * jax.nn.silu(gate)

    def merge(o_a, o_r, g_a, g_r):
        return (jax.nn.sigmoid(g_a) * (o_a @ w_o_attn) + jax.nn.sigmoid(g_r) * (o_r @ w_o_hgrn)) @ w_out

    y = merge(o_att, readout(o_h, hg), ga, gh)
    if not need_ctx:
        return y, None
    o_attc = context_attention(q_heads(aqc), kc, vc, sink)
    yc = merge(o_attc, readout(o_hc, hgc), gac, ghc)
    return y, yc


def setup_inputs(seed: int = 0) -> dict:
    key = jax.random.key(seed)
    ks = jax.random.split(key, 20)
    f32 = jnp.float32

    def nrm(k, shape, scale):
        return jax.random.normal(k, shape, f32) * scale

    D = D_MODEL
    return {
        'x': nrm(ks[0], (BATCH, SEQ, D), 1.0),
        'c': nrm(ks[1], (BATCH, D), 1.0),
        'ctx': nrm(ks[2], (BATCH, CTX_LEN, D), 1.0),
        'c_ctx': nrm(ks[3], (D,), 1.0),
        'w_ada': nrm(ks[4], (DEPTH, D, N_MOD * D), 0.5 * D ** -0.5),
        'b_ada': nrm(ks[5], (DEPTH, N_MOD * D), 0.02),
        'norm_pre': 1.0 + nrm(ks[6], (DEPTH, 3, D), 0.02),
        'norm_post': 1.0 + nrm(ks[7], (DEPTH, 3, D), 0.02),
        'ffn1_w_in': nrm(ks[8], (DEPTH, D, 2 * D_FF), D ** -0.5),
        'ffn1_w_out': nrm(ks[9], (DEPTH, D_FF, D), D_FF ** -0.5),
        'ffn2_w_in': nrm(ks[10], (DEPTH, D, 2 * D_FF), D ** -0.5),
        'ffn2_w_out': nrm(ks[11], (DEPTH, D_FF, D), D_FF ** -0.5),
        'mix_w_in': nrm(ks[12], (DEPTH, D, IN_WIDTH), D ** -0.5),
        'attn_sink': nrm(ks[13], (DEPTH, ATT_HEADS), 0.5),
        'hgrn_lb_fwd': nrm(ks[14], (DEPTH + 1, HG_WIDTH), 0.5),
        'hgrn_lb_bwd': nrm(ks[15], (DEPTH + 1, HG_WIDTH), 0.5),
        'hgrn_norm': 1.0 + nrm(ks[16], (DEPTH, HG_WIDTH), 0.02),
        'w_o_attn': nrm(ks[17], (DEPTH, ATT_WIDTH, D), ATT_WIDTH ** -0.5),
        'w_o_hgrn': nrm(ks[18], (DEPTH, HG_WIDTH, D), HG_WIDTH ** -0.5),
        'w_out': nrm(ks[19], (DEPTH, D, D), D ** -0.5),
    }


def reference(x, c, ctx, c_ctx, w_ada, b_ada, norm_pre, norm_post, ffn1_w_in, ffn1_w_out,
              ffn2_w_in, ffn2_w_out, mix_w_in, attn_sink, hgrn_lb_fwd, hgrn_lb_bwd, hgrn_norm,
              w_o_attn, w_o_hgrn, w_out):
    B, T, D = x.shape
    lb_f_all = jnp.cumsum(jax.nn.softmax(hgrn_lb_fwd.astype(jnp.float32), axis=0), axis=0)
    lb_b_all = jnp.cumsum(jax.nn.softmax(hgrn_lb_bwd.astype(jnp.float32), axis=0), axis=0)
    xc = ctx
    for l in range(DEPTH):
        need_ctx = l < DEPTH - 1
        mod = (jax.nn.silu(c) @ w_ada[l] + b_ada[l]).reshape(B, N_MOD, 1, D)
        mod_c = (jax.nn.silu(c_ctx) @ w_ada[l] + b_ada[l]).reshape(N_MOD, D)
        m = [mod[:, j] for j in range(N_MOD)]
        mc = [mod_c[j] for j in range(N_MOD)]
        h = ada_pre(x, norm_pre[l, 0], m[0], m[1])
        x = ada_post(x, swiglu(h, ffn1_w_in[l], ffn1_w_out[l]), norm_post[l, 0], m[2], 0.5)
        hc = ada_pre(xc, norm_pre[l, 0], mc[0], mc[1])
        xc = ada_post(xc, swiglu(hc, ffn1_w_in[l], ffn1_w_out[l]), norm_post[l, 0], mc[2], 0.5)
        h = ada_pre(x, norm_pre[l, 1], m[3], m[4])
        hc = ada_pre(xc, norm_pre[l, 1], mc[3], mc[4])
        y, yc = mixer(h, hc, mix_w_in[l], attn_sink[l], lb_f_all[l], lb_b_all[l], hgrn_norm[l],
                      w_o_attn[l], w_o_hgrn[l], w_out[l], need_ctx)
        x = ada_post(x, y, norm_post[l, 1], m[5], 1.0)
        h = ada_pre(x, norm_pre[l, 2], m[6], m[7])
        x = ada_post(x, swiglu(h, ffn2_w_in[l], ffn2_w_out[l]), norm_post[l, 2], m[8], 0.5)
        if need_ctx:
            xc = ada_post(xc, yc, norm_post[l, 1], mc[5], 1.0)
            hc = ada_pre(xc, norm_pre[l, 2], mc[6], mc[7])
            xc = ada_post(xc, swiglu(hc, ffn2_w_in[l], ffn2_w_out[l]), norm_post[l, 2], mc[8], 0.5)
    return x
```

```cpp
#include <hip/hip_runtime.h>
#include <hip/hip_cooperative_groups.h>
#include <cstdio>
namespace cg = cooperative_groups;

#ifndef MULTI_LAUNCH
#define MULTI_LAUNCH 0
#endif

#ifndef PHASE_MASK
#define PHASE_MASK 0xffff
#endif
#define PH_ON(n) (((PHASE_MASK) >> (n)) & 1)
#define LAS __attribute__((address_space(3)))
typedef unsigned short bf16_t;
typedef short bf16x8 __attribute__((ext_vector_type(8)));
typedef float f32x4 __attribute__((ext_vector_type(4)));
typedef unsigned u32x4 __attribute__((ext_vector_type(4)));
typedef unsigned u32x2 __attribute__((ext_vector_type(2)));

constexpr int D = 1024, NB = 16, T = 2048, L = 256, MLAT = NB * T, MCTX = NB * L, MALL = MLAT + MCTX;
constexpr int DFF = 2816, INW = 5376, NMOD = 9;
constexpr float EPS = 1e-6f;
constexpr int NPH = 16;
constexpr int LDS_BYTES = 139264 + 16;

constexpr size_t MiB = 1u << 20;
constexpr size_t OFF_WFFN_IN = 0;
constexpr size_t OFF_WFFN_OUT = 11 * MiB;
constexpr size_t OFF_WMIX = 11 * MiB + 5632 * 1024;
constexpr size_t OFF_WOA = 27 * MiB;
constexpr size_t OFF_WOH = 28 * MiB;
constexpr size_t OFF_WOUT = 29 * MiB;
constexpr size_t OFF_MOD = 31 * MiB;
constexpr size_t OFF_ROPE = 31 * MiB + 640 * 1024;
constexpr size_t OFF_BAR = 32 * MiB;
constexpr size_t OFF_HA = 33 * MiB;
constexpr size_t OFF_ODIR = 33 * MiB;
constexpr size_t OFF_Y = 105 * MiB;
constexpr size_t OFF_QBUF = 105 * MiB;
constexpr size_t OFF_OR = 105 * MiB;
constexpr size_t OFF_KALL = 137 * MiB;
constexpr size_t OFF_VT = 146 * MiB;
constexpr size_t OFF_OATT = 155 * MiB;
constexpr size_t OFF_ACT = 177 * MiB;
constexpr size_t OFF_PART = 177 * MiB;
constexpr size_t OFF_HBUF = 187 * MiB;
constexpr size_t OFF_U = 187 * MiB;
constexpr size_t OFF_GBUF = 331 * MiB;
constexpr size_t OFF_X2 = 400 * MiB;

struct Params {
    const float *x, *c, *ctx, *c_ctx, *w_ada, *b_ada, *norm_pre, *norm_post, *ffn1_w_in, *ffn1_w_out, *ffn2_w_in, *ffn2_w_out,
        *mix_w_in, *attn_sink, *lb_fwd, *lb_bwd, *hgrn_norm, *w_o_attn, *w_o_hgrn, *w_out;
    float* out;
    unsigned char* ws;
};

typedef __bf16 bf16x2_t __attribute__((ext_vector_type(2)));
__device__ __forceinline__ unsigned cvt_pk_bf16(float lo, float hi) { bf16x2_t v; v[0] = (__bf16)lo; v[1] = (__bf16)hi; return __builtin_bit_cast(unsigned, v); }
__device__ __forceinline__ bf16_t f2bf(float f) { return __builtin_bit_cast(bf16_t, (__bf16)f); }
__device__ __forceinline__ float bf2f(bf16_t b) { return __uint_as_float(((unsigned)b) << 16); }
__device__ __forceinline__ float bflo(unsigned w) { return __uint_as_float(w << 16); }
__device__ __forceinline__ float bfhi(unsigned w) { return __uint_as_float(w & 0xffff0000u); }
__device__ __forceinline__ float sigmoidf_(float v) { return __builtin_amdgcn_rcpf(1.0f + __builtin_amdgcn_exp2f(v * -1.44269504f)); }
__device__ __forceinline__ float siluf_(float v) { return v * __builtin_amdgcn_rcpf(1.0f + __builtin_amdgcn_exp2f(v * -1.44269504f)); }
__device__ __forceinline__ float wave_sum(float v) {
#pragma unroll
    for (int o = 32; o >= 1; o >>= 1) v += __shfl_xor(v, o);
    return v;
}

constexpr int BM = 256, BK = 64, HALF = 128, HTB = HALF * BK * 2, NXCD = 8, WGM = 8;
__device__ __forceinline__ int lds_byte(int r, int c) { const int st = (r >> 4) * 2 + (c >> 5), rr = r & 15, cc = c & 31, ob = rr * 64 + cc * 2; return st * 1024 + (ob ^ (((ob >> 9) & 1) << 5)); }
__device__ __forceinline__ void stage_rc(int b, int& R, int& C) { const int st = b / 1024, sb = b % 1024, swz = sb ^ (((sb >> 9) & 1) << 5); R = (st >> 1) * 16 + swz / 64; C = (st & 1) * 32 + (swz % 64) / 2; }
__device__ __forceinline__ int perm32(int rho) { const int n = rho >> 4, i = rho & 15; return 8 * (i >> 2) + 4 * n + (i & 3); }

struct Unit { int pm, pn, part; };

__device__ __forceinline__ void rect_map(int Lidx, int nwg, int nM, int nN, int& pm, int& pn) {
    int wgid = Lidx;
    { const int q = nwg / NXCD, r = nwg % NXCD, xcd = wgid % NXCD, off = wgid / NXCD; wgid = (xcd < r ? xcd * (q + 1) : r * (q + 1) + (xcd - r) * q) + off; }
    const int nig = WGM * nN, gid = wgid / nig, fm = gid * WGM, gsz = (nM - fm) < WGM ? (nM - fm) : WGM;
    pm = fm + ((wgid % nig) % gsz); pn = (wgid % nig) / gsz;
}

struct RectOrder {
    const char *A, *B; int K, nM, nN, nwg, G, c, pm0;
    __device__ __forceinline__ bool next(int i, Unit& u) const {
        const int Lidx = i * G + c; if (Lidx >= nwg) return false;
        rect_map(Lidx, nwg, nM, nN, u.pm, u.pn); u.pm += pm0; u.part = 0; return true;
    }
    __device__ __forceinline__ const char* aptr(const Unit& u) const { return A + (size_t)u.pm * 512 * K; }
    __device__ __forceinline__ const char* bptr(const Unit& u) const { return B + (size_t)u.pn * 512 * K; }
};
struct MixOrder {
    const char *A, *B; int G, c;
    __device__ __forceinline__ bool next(int i, Unit& u) const {
        const int Lidx = i * G + c; if (Lidx >= 2800) return false;
        if (Lidx < 2688) rect_map(Lidx, 2688, 128, 21, u.pm, u.pn);
        else { const int j = Lidx - 2688, cs = j >> 4; u.pm = 128 + (j & 15); u.pn = cs == 0 ? 2 : 4 + cs; }
        u.part = 0; return true;
    }
    __device__ __forceinline__ const char* aptr(const Unit& u) const { return A + (size_t)u.pm * 512 * 1024; }
    __device__ __forceinline__ const char* bptr(const Unit& u) const { return B + (size_t)u.pn * 512 * 1024; }
};
struct MergeOrder {
    const char *A0, *B0, *A1, *B1; int G, c;
    __device__ __forceinline__ bool next(int i, Unit& u) const {
        const int Lidx = (i >> 1) * G + c; if (Lidx >= 512) return false;
        rect_map(Lidx, 512, 128, 4, u.pm, u.pn); u.part = i & 1; return true;
    }
    __device__ __forceinline__ const char* aptr(const Unit& u) const { return (u.part ? A1 : A0) + (size_t)u.pm * 512 * 512; }
    __device__ __forceinline__ const char* bptr(const Unit& u) const { return (u.part ? B1 : B0) + (size_t)u.pn * 512 * 512; }
};

typedef f32x4 Acc[2][2][4][2];

struct EpiSwiglu {
    static constexpr bool PERM = true;
    bf16_t* act;
    __device__ __forceinline__ bool operator()(Acc& acc, const Unit& u, int wr, int wc, int fr, int fq) const {
#pragma unroll
        for (int ai = 0; ai < 2; ++ai)
#pragma unroll
            for (int m = 0; m < 4; ++m) {
                const int r = u.pm * BM + ai * HALF + wr * 64 + m * 16 + fr;
                float v[8];
#pragma unroll
                for (int n = 0; n < 2; ++n)
#pragma unroll
                    for (int j = 0; j < 4; ++j) { const float g = acc[ai][0][m][n][j], up = acc[ai][1][m][n][j]; v[n * 4 + j] = (g * up) * __builtin_amdgcn_rcpf(1.0f + __builtin_amdgcn_exp2f(g * -1.44269504f)); }
                u32x4 w; w.x = cvt_pk_bf16(v[0], v[1]); w.y = cvt_pk_bf16(v[2], v[3]); w.z = cvt_pk_bf16(v[4], v[5]); w.w = cvt_pk_bf16(v[6], v[7]);
                *(u32x4*)(act + (size_t)r * DFF + u.pn * 128 + wc * 32 + fq * 8) = w;
            }
        return false;
    }
};
struct EpiBf16 {
    static constexpr bool PERM = true;
    bf16_t* C; int ldc;
    __device__ __forceinline__ bool operator()(Acc& acc, const Unit& u, int wr, int wc, int fr, int fq) const {
#pragma unroll
        for (int ai = 0; ai < 2; ++ai)
#pragma unroll
            for (int m = 0; m < 4; ++m) {
                const int r = u.pm * BM + ai * HALF + wr * 64 + m * 16 + fr;
#pragma unroll
                for (int bj = 0; bj < 2; ++bj) {
                    const f32x4 v0 = acc[ai][bj][m][0], v1 = acc[ai][bj][m][1];
                    u32x4 w; w.x = cvt_pk_bf16(v0[0], v0[1]); w.y = cvt_pk_bf16(v0[2], v0[3]); w.z = cvt_pk_bf16(v1[0], v1[1]); w.w = cvt_pk_bf16(v1[2], v1[3]);
                    *(u32x4*)(C + (size_t)r * ldc + u.pn * BM + bj * HALF + wc * 32 + fq * 8) = w;
                }
            }
        return false;
    }
};
struct EpiMerge {
    static constexpr bool PERM = true;
    const bf16_t* gbuf; bf16_t* U;
    __device__ __forceinline__ bool operator()(Acc& acc, const Unit& u, int wr, int wc, int fr, int fq) const {
        const bool first = u.part == 0;
        const int colb = u.pn * BM + wc * 32 + fq * 8;
        const int rowb = u.pm * BM + wr * 64 + fr;
        u32x4 ghc[2], gac[2], ghn[2], gan[2];
#define MG_LOAD(GH, GA, it) do { const int r_ = rowb + ((it) >> 2) * HALF + ((it) & 3) * 16; \
        _Pragma("unroll") for (int bj = 0; bj < 2; ++bj) { GH[bj] = *(const u32x4*)(gbuf + (size_t)r_ * 2560 + 1536 + colb + bj * HALF); \
            if (first) GA[bj] = *(const u32x4*)(gbuf + (size_t)r_ * 2560 + 512 + colb + bj * HALF); else GA[bj] = GH[bj]; } } while (0)
        MG_LOAD(ghc, gac, 0);
#pragma unroll
        for (int it = 0; it < 8; ++it) {
            const int ai = it >> 2, m = it & 3;
            if (it < 7) MG_LOAD(ghn, gan, it + 1);
            const int r = rowb + ai * HALF + m * 16;
#pragma unroll
            for (int bj = 0; bj < 2; ++bj) {
                if (first) {
#pragma unroll
                    for (int q = 0; q < 4; ++q) {
                        const float a0 = bflo(gac[bj][q]), a1 = bfhi(gac[bj][q]), h0 = bflo(ghc[bj][q]), h1 = bfhi(ghc[bj][q]);
                        const float r0 = (1.0f + __builtin_amdgcn_exp2f(h0 * -1.44269504f)) * __builtin_amdgcn_rcpf(1.0f + __builtin_amdgcn_exp2f(a0 * -1.44269504f));
                        const float r1 = (1.0f + __builtin_amdgcn_exp2f(h1 * -1.44269504f)) * __builtin_amdgcn_rcpf(1.0f + __builtin_amdgcn_exp2f(a1 * -1.44269504f));
                        acc[ai][bj][m][q >> 1][(q & 1) * 2] *= r0; acc[ai][bj][m][q >> 1][(q & 1) * 2 + 1] *= r1;
                    }
                } else {
                    float v[8];
#pragma unroll
                    for (int q = 0; q < 4; ++q) {
                        const float h0 = bflo(ghc[bj][q]), h1 = bfhi(ghc[bj][q]);
                        v[q * 2] = acc[ai][bj][m][q >> 1][(q & 1) * 2] * sigmoidf_(h0); v[q * 2 + 1] = acc[ai][bj][m][q >> 1][(q & 1) * 2 + 1] * sigmoidf_(h1);
                    }
                    u32x4 w; w.x = cvt_pk_bf16(v[0], v[1]); w.y = cvt_pk_bf16(v[2], v[3]); w.z = cvt_pk_bf16(v[4], v[5]); w.w = cvt_pk_bf16(v[6], v[7]);
                    *(u32x4*)(U + (size_t)r * D + colb + bj * HALF) = w;
                }
            }
#pragma unroll
            for (int bj = 0; bj < 2; ++bj) { ghc[bj] = ghn[bj]; gac[bj] = gan[bj]; }
        }
#undef MG_LOAD
        return first;
    }
};
struct EpiMixIn {
    static constexpr bool PERM = true;
    bf16_t *qbuf, *kall, *vt, *hbuf, *gbuf; const LAS float2* rope;
    __device__ __forceinline__ bool operator()(Acc& acc, const Unit& u, int wr, int wc, int fr, int fq) const {
        const int pn = u.pn;
        const int rowb = u.pm * BM + wr * 64 + fr;
        if (pn <= 2) {
            const bool lat = u.pm < 128;
#pragma unroll
            for (int ai = 0; ai < 2; ++ai) {
            float2 cs[4][4];
#pragma unroll
            for (int it = 0; it < 4; ++it) {
                const int r = rowb + ai * HALF + it * 16;
                const int t = r & (T - 1), pos = (wc & 1) ? (t & 63) : (t >> 6);
#pragma unroll
                for (int j = 0; j < 4; ++j) { const LAS float* rp_ = (const LAS float*)(rope + pos * 16 + fq * 4 + j); cs[it][j] = lat ? make_float2(rp_[0], rp_[1]) : make_float2(1.0f, 0.0f); }
            }
#pragma unroll
            for (int it = 0; it < 4; ++it) {
                const int m = it;
                const int r = rowb + ai * HALF + m * 16;
                if (pn < 2) {
#pragma unroll
                    for (int bj = 0; bj < 2; ++bj) {
                        const f32x4 x1 = acc[ai][bj][m][0], x2 = acc[ai][bj][m][1];
                        float o1[4], o2[4];
#pragma unroll
                        for (int j = 0; j < 4; ++j) { o1[j] = (x1[j] * cs[it][j].x - x2[j] * cs[it][j].y) * 0.18033688f; o2[j] = (x1[j] * cs[it][j].y + x2[j] * cs[it][j].x) * 0.18033688f; }
                        bf16_t* dst = qbuf + (size_t)r * 512 + pn * 256 + bj * 128 + wc * 32 + fq * 4;
                        u32x2 w0, w1; w0.x = cvt_pk_bf16(o1[0], o1[1]); w0.y = cvt_pk_bf16(o1[2], o1[3]); w1.x = cvt_pk_bf16(o2[0], o2[1]); w1.y = cvt_pk_bf16(o2[2], o2[3]);
                        *(u32x2*)dst = w0; *(u32x2*)(dst + 16) = w1;
                    }
                } else {
                    const int b = lat ? (r >> 11) : ((r - MLAT) >> 8);
                    const int tpos = lat ? (r & (T - 1)) : (T + ((r - MLAT) & (L - 1)));
                    const int kvh = wc >> 1;
                    f32x4 x1 = acc[ai][0][m][0], x2 = acc[ai][0][m][1];
#pragma unroll
                    for (int j = 0; j < 4; ++j) { const float a = x1[j], bb = x2[j]; x1[j] = a * cs[it][j].x - bb * cs[it][j].y; x2[j] = a * cs[it][j].y + bb * cs[it][j].x; }
                    bf16_t* kd = kall + ((size_t)(b * 2 + kvh) * 2304 + tpos) * 64 + (wc & 1) * 32 + fq * 4;
                    u32x2 w0, w1; w0.x = cvt_pk_bf16(x1[0], x1[1]); w0.y = cvt_pk_bf16(x1[2], x1[3]); w1.x = cvt_pk_bf16(x2[0], x2[1]); w1.y = cvt_pk_bf16(x2[2], x2[3]);
                    *(u32x2*)kd = w0; *(u32x2*)(kd + 16) = w1;
                    const f32x4 v1 = acc[ai][1][m][0], v2 = acc[ai][1][m][1];
                    bf16_t* vd = vt + ((size_t)(b * 2 + kvh) * 64 + (wc & 1) * 32 + fq * 8) * 2304 + tpos;
#pragma unroll
                    for (int j = 0; j < 4; ++j) { vd[(size_t)j * 2304] = f2bf(v1[j]); vd[(size_t)(j + 4) * 2304] = f2bf(v2[j]); }
                }
            }
            }
        } else if (pn <= 4) {
#pragma unroll
            for (int ai = 0; ai < 2; ++ai)
#pragma unroll
                for (int m = 0; m < 4; ++m) {
                    const int r = rowb + ai * HALF + m * 16;
                    bf16_t* dst = hbuf + (size_t)r * 2048 + (pn - 3) * 256;
#pragma unroll
                    for (int bj = 0; bj < 2; ++bj) {
                        const f32x4 v0 = acc[ai][bj][m][0], v1 = acc[ai][bj][m][1];
                        u32x4 w; w.x = cvt_pk_bf16(siluf_(v0[0]), siluf_(v0[1])); w.y = cvt_pk_bf16(siluf_(v0[2]), siluf_(v0[3]));
                        w.z = cvt_pk_bf16(siluf_(v1[0]), siluf_(v1[1])); w.w = cvt_pk_bf16(siluf_(v1[2]), siluf_(v1[3]));
                        *(u32x4*)(dst + bj * 128 + wc * 32 + fq * 8) = w;
                    }
                }
        } else {
#pragma unroll
            for (int ai = 0; ai < 2; ++ai)
#pragma unroll
                for (int m = 0; m < 4; ++m) {
                    const int r = rowb + ai * HALF + m * 16;
                    bf16_t* dst = pn < 11 ? hbuf + (size_t)r * 2048 + (pn - 3) * 256 : gbuf + (size_t)r * 2560 + (pn - 11) * 256;
#pragma unroll
                    for (int bj = 0; bj < 2; ++bj) {
                        const f32x4 v0 = acc[ai][bj][m][0], v1 = acc[ai][bj][m][1];
                        u32x4 w; w.x = cvt_pk_bf16(v0[0], v0[1]); w.y = cvt_pk_bf16(v0[2], v0[3]); w.z = cvt_pk_bf16(v1[0], v1[1]); w.w = cvt_pk_bf16(v1[2], v1[3]);
                        *(u32x4*)(dst + bj * 128 + wc * 32 + fq * 8) = w;
                    }
                }
        }
        return false;
    }
};

template <class Epi, class Sched>
__device__ __forceinline__ void gemm_phase(LAS unsigned char* lds, const int K, const Sched& S, const Epi& E, const int tid) {
    const int wid = __builtin_amdgcn_readfirstlane(tid >> 6), lane = tid & 63, wr = wid >> 2, wc = wid & 3, fr = lane & 15, fq = lane >> 4;
    const int nt = K / BK;
    unsigned voffA[2], voffB[2];
#pragma unroll
    for (int i = 0; i < 2; ++i) { int R, C; stage_rc(tid * 16 + i * 8192, R, C); const int Rb = Epi::PERM ? ((R & ~31) + perm32(R & 31)) : R;
        voffA[i] = (unsigned)(R * K + C) * 2u; voffB[i] = (unsigned)(Rb * K + C) * 2u; }
    const size_t kstep = (size_t)(BK * 2);
    const size_t hstep = (size_t)HALF * K * 2;
    const unsigned ldsw = (unsigned)wid * 1024u;
    const int aoff = lds_byte(wr * 64 + fr, fq * 8), boff = lds_byte(wc * 32 + fr, fq * 8);
#define PG8_SA(b, h) (((b) * 2 + (h)) * HTB)
#define PG8_SB(b, h) ((4 + (b) * 2 + (h)) * HTB)
#define PG8_STAGE(bufoff, gbase, voff) do { _Pragma("unroll") for (int _i = 0; _i < 2; ++_i) \
        __builtin_amdgcn_global_load_lds((const unsigned*)((const char*)(gbase) + (voff)[_i]), (LAS unsigned*)(lds + (bufoff) + ldsw + _i * 8192), 16, 0, 0); } while (0)
#define PG8_LDA(dst, b, h) do { _Pragma("unroll") for (int m = 0; m < 4; ++m) _Pragma("unroll") for (int k = 0; k < 2; ++k) dst[m][k] = *(const LAS bf16x8*)(lds + PG8_SA(b, h) + aoff + m * 2048 + k * 1024); } while (0)
#define PG8_LDB(dst, b, h) do { _Pragma("unroll") for (int n = 0; n < 2; ++n) _Pragma("unroll") for (int k = 0; k < 2; ++k) dst[n][k] = *(const LAS bf16x8*)(lds + PG8_SB(b, h) + boff + n * 2048 + k * 1024); } while (0)
#define PG8_MMA(ai, bj, At, Bt) do { __builtin_amdgcn_s_setprio(1); _Pragma("unroll") for (int m = 0; m < 4; ++m) _Pragma("unroll") for (int n = 0; n < 2; ++n) _Pragma("unroll") for (int k = 0; k < 2; ++k) \
        acc[ai][bj][m][n] = __builtin_amdgcn_mfma_f32_16x16x32_bf16(Bt[n][k], At[m][k], acc[ai][bj][m][n], 0, 0, 0); __builtin_amdgcn_s_setprio(0); } while (0)
#define PG8_WAIT_V(n) asm volatile("s_waitcnt vmcnt(" #n ")" ::: "memory")
#define PG8_WAIT_L(n) asm volatile("s_waitcnt lgkmcnt(" #n ")" ::: "memory")
#define PG8_BAR __builtin_amdgcn_s_barrier()
#define PG8_SCHED __builtin_amdgcn_sched_barrier(0)
    Unit cur, nxt; int ui = 0;
    if (!S.next(0, cur)) return;
    Acc acc;
#pragma unroll
    for (int a = 0; a < 2; ++a)
#pragma unroll
        for (int b = 0; b < 2; ++b)
#pragma unroll
            for (int m = 0; m < 4; ++m)
#pragma unroll
                for (int n = 0; n < 2; ++n) acc[a][b][m][n] = (f32x4){0.f, 0.f, 0.f, 0.f};
    bf16x8 At[4][2], B0[2][2], B1[2][2];
    const char* cA = S.aptr(cur); const char* cB = S.bptr(cur);
    PG8_STAGE(PG8_SB(0, 0), cB, voffB); PG8_STAGE(PG8_SA(0, 0), cA, voffA); PG8_STAGE(PG8_SB(0, 1), cB + hstep, voffB); PG8_STAGE(PG8_SA(0, 1), cA + hstep, voffA);
    if (wr == 1) PG8_BAR;
    PG8_WAIT_V(4); PG8_BAR;
    PG8_STAGE(PG8_SB(1, 0), cB + kstep, voffB); PG8_STAGE(PG8_SA(1, 0), cA + kstep, voffA); PG8_STAGE(PG8_SB(1, 1), cB + hstep + kstep, voffB);
    PG8_WAIT_V(6); PG8_BAR;
    for (;;) {
        const bool has_next = S.next(ui + 1, nxt);
        const char* nA = has_next ? S.aptr(nxt) : cA; const char* nB = has_next ? S.bptr(nxt) : cB;
        for (int t = 0; t < nt; t += 2) {
            const bool last = (t == nt - 2);
            const char* a1 = cA + (size_t)(t + 1) * kstep;
            const char* a2 = last ? nA : cA + (size_t)(t + 2) * kstep; const char* b2 = last ? nB : cB + (size_t)(t + 2) * kstep;
            const char* a3 = a2 + kstep; const char* b3 = b2 + kstep;
            PG8_LDB(B0, 0, 0); PG8_SCHED; PG8_LDA(At, 0, 0); PG8_STAGE(PG8_SA(1, 1), a1 + hstep, voffA);
            PG8_WAIT_L(8); PG8_BAR; PG8_WAIT_L(0); PG8_MMA(0, 0, At, B0); PG8_BAR; PG8_SCHED;
            PG8_LDB(B1, 0, 1); PG8_STAGE(PG8_SB(0, 0), b2, voffB);
            PG8_BAR; PG8_WAIT_L(0); PG8_MMA(0, 1, At, B1); PG8_BAR;
            PG8_LDA(At, 0, 1); PG8_STAGE(PG8_SA(0, 0), a2, voffA);
            PG8_BAR; PG8_WAIT_L(0); PG8_MMA(1, 0, At, B0); PG8_BAR; PG8_SCHED;
            PG8_STAGE(PG8_SB(0, 1), b2 + hstep, voffB);
            PG8_WAIT_V(6); PG8_BAR; PG8_MMA(1, 1, At, B1); PG8_BAR;
            PG8_LDB(B0, 1, 0); PG8_SCHED; PG8_LDA(At, 1, 0); PG8_STAGE(PG8_SA(0, 1), a2 + hstep, voffA);
            PG8_WAIT_L(8); PG8_BAR; PG8_WAIT_L(0); PG8_MMA(0, 0, At, B0); PG8_BAR; PG8_SCHED;
            PG8_LDB(B1, 1, 1); PG8_STAGE(PG8_SB(1, 0), b3, voffB);
            PG8_BAR; PG8_WAIT_L(0); PG8_MMA(0, 1, At, B1); PG8_BAR;
            PG8_LDA(At, 1, 1); PG8_STAGE(PG8_SA(1, 0), a3, voffA);
            PG8_BAR; PG8_WAIT_L(0); PG8_MMA(1, 0, At, B0); PG8_BAR; PG8_SCHED;
            PG8_STAGE(PG8_SB(1, 1), b3 + hstep, voffB);
            PG8_WAIT_V(6); PG8_BAR; PG8_MMA(1, 1, At, B1); PG8_BAR;
        }
        const bool keep = E(acc, cur, wr, wc, fr, fq);
        if (!has_next) break;
        if (!keep) {
#pragma unroll
            for (int a = 0; a < 2; ++a)
#pragma unroll
                for (int b = 0; b < 2; ++b)
#pragma unroll
                    for (int m = 0; m < 4; ++m)
#pragma unroll
                        for (int n = 0; n < 2; ++n) acc[a][b][m][n] = (f32x4){0.f, 0.f, 0.f, 0.f};
        }
        cur = nxt; cA = nA; cB = nB; ++ui;
    }
    PG8_WAIT_V(0);
    if (wr == 0) PG8_BAR;
    PG8_BAR;
#undef PG8_SA
#undef PG8_SB
#undef PG8_STAGE
#undef PG8_LDA
#undef PG8_LDB
#undef PG8_MMA
#undef PG8_WAIT_V
#undef PG8_WAIT_L
#undef PG8_BAR
#undef PG8_SCHED
}

struct TileDesc { const float* W; bf16_t* Bt; int K, N, mapmode, tile; };
__device__ __forceinline__ TileDesc tile_desc(const Params& p, unsigned char* ws, int t, int set) {
    TileDesc d;
    if (set == 0) {
        if (t < 1408) { d.W = p.ffn1_w_in; d.Bt = (bf16_t*)(ws + OFF_WFFN_IN); d.K = D; d.N = 2 * DFF; d.mapmode = 1; d.tile = t; }
        else if ((t -= 1408) < 704) { d.W = p.ffn1_w_out; d.Bt = (bf16_t*)(ws + OFF_WFFN_OUT); d.K = DFF; d.N = D; d.mapmode = 0; d.tile = t; }
        else if ((t -= 704) < 1344) { d.W = p.mix_w_in; d.Bt = (bf16_t*)(ws + OFF_WMIX); d.K = D; d.N = INW; d.mapmode = 2; d.tile = t; }
        else if ((t -= 1344) < 128) { d.W = p.w_o_attn; d.Bt = (bf16_t*)(ws + OFF_WOA); d.K = 512; d.N = D; d.mapmode = 0; d.tile = t; }
        else if ((t -= 128) < 128) { d.W = p.w_o_hgrn; d.Bt = (bf16_t*)(ws + OFF_WOH); d.K = 512; d.N = D; d.mapmode = 0; d.tile = t; }
        else { t -= 128; d.W = p.w_out; d.Bt = (bf16_t*)(ws + OFF_WOUT); d.K = D; d.N = D; d.mapmode = 0; d.tile = t; }
    } else {
        if (t < 1408) { d.W = p.ffn2_w_in; d.Bt = (bf16_t*)(ws + OFF_WFFN_IN); d.K = D; d.N = 2 * DFF; d.mapmode = 1; d.tile = t; }
        else { d.W = p.ffn2_w_out; d.Bt = (bf16_t*)(ws + OFF_WFFN_OUT); d.K = DFF; d.N = D; d.mapmode = 0; d.tile = t - 1408; }
    }
    return d;
}
__device__ __forceinline__ void convert_tiles(const Params& p, unsigned char* ws, int set, int ntiles, int first, int stride, LAS float* tl, int tid) {
    if (first >= ntiles) return;
    const int kk = tid >> 4, n4 = (tid & 15) * 4;
#define TILE_LOAD(dsc, A0, A1) do { const int ntn_ = (dsc).N >> 6, tk_ = (dsc).tile / ntn_, tn_ = (dsc).tile - tk_ * ntn_; \
        const float* src_ = (dsc).W + (size_t)(tk_ * 64 + kk) * (dsc).N + tn_ * 64 + n4; A0 = *(const f32x4*)src_; A1 = *(const f32x4*)(src_ + (size_t)32 * (dsc).N); } while (0)
#define CV_BAR() do { asm volatile("s_waitcnt lgkmcnt(0)" ::: "memory"); __builtin_amdgcn_s_barrier(); asm volatile("" ::: "memory"); } while (0)
    TileDesc cur = tile_desc(p, ws, first, set); f32x4 v0, v1; TILE_LOAD(cur, v0, v1);
    for (int t = first; t < ntiles; t += stride) {
        TileDesc nxt = cur; f32x4 n0 = v0, n1 = v1;
        if (t + stride < ntiles) { nxt = tile_desc(p, ws, t + stride, set); TILE_LOAD(nxt, n0, n1); }
#pragma unroll
        for (int j = 0; j < 4; ++j) { tl[kk * 65 + n4 + j] = v0[j]; tl[(kk + 32) * 65 + n4 + j] = v1[j]; }
        CV_BAR();
        {
            const int ntn = cur.N >> 6, tk = cur.tile / ntn, tn = cur.tile - tk * ntn, k0 = tk * 64, n0c = tn * 64;
            const int n = tid >> 3, ks = tid & 7; float v[8];
#pragma unroll
            for (int j = 0; j < 8; ++j) v[j] = tl[(ks * 8 + j) * 65 + n];
            int col = n0c + n, row = col;
            if (cur.mapmode == 1) { const int bj = col >= DFF ? 1 : 0, rem = col - bj * DFF; row = (rem >> 7) * 256 + bj * 128 + (rem & 127); }
            if (cur.mapmode == 2 && col < 640) { const int i32 = col & 31; row = (col & ~31) + 8 * ((i32 >> 2) & 3) + 4 * (i32 >> 4) + (i32 & 3); }
            u32x4 w; w.x = cvt_pk_bf16(v[0], v[1]); w.y = cvt_pk_bf16(v[2], v[3]); w.z = cvt_pk_bf16(v[4], v[5]); w.w = cvt_pk_bf16(v[6], v[7]);
            *(u32x4*)(cur.Bt + (size_t)row * cur.K + k0 + ks * 8) = w;
        }
        CV_BAR();
        cur = nxt; v0 = n0; v1 = n1;
    }
    __syncthreads();
#undef TILE_LOAD
#undef CV_BAR
}

__device__ __forceinline__ void mod_partial_item(const Params& p, int item, LAS float* sl, int tid) {
    const int ks = item / 18, chunk = item - ks * 18, col = chunk * 512 + tid;
    for (int i = tid; i < 17 * 64; i += 512) { const int b = i >> 6, kk = i & 63; const float cv = b < 16 ? p.c[b * D + ks * 64 + kk] : p.c_ctx[ks * 64 + kk]; sl[i] = siluf_(cv); }
    __syncthreads();
    float acc[17];
#pragma unroll
    for (int b = 0; b < 17; ++b) acc[b] = 0.f;
    const float* w = p.w_ada + (size_t)(ks * 64) * (NMOD * D) + col;
    for (int k0 = 0; k0 < 64; k0 += 16) {
        float wv[16];
#pragma unroll
        for (int j = 0; j < 16; ++j) wv[j] = w[(size_t)(k0 + j) * (NMOD * D)];
#pragma unroll
        for (int j = 0; j < 16; ++j)
#pragma unroll
            for (int b = 0; b < 17; ++b) acc[b] += sl[b * 64 + k0 + j] * wv[j];
    }
    float* part = (float*)(p.ws + OFF_PART);
#pragma unroll
    for (int b = 0; b < 17; ++b) part[(size_t)(ks * 17 + b) * (NMOD * D) + col] = acc[b];
    __syncthreads();
}

__device__ __forceinline__ void row_op(const float* src, const bf16_t* y, float w, const float* gate, const float* gpost, float* xdst,
                                       const float* gpre, const float* shift, const float* scale, bf16_t* hdst, int lane) {
    f32x4 v[4];
#pragma unroll
    for (int i = 0; i < 4; ++i) v[i] = *(const f32x4*)(src + i * 256 + lane * 4);
    if (y) {
        f32x4 yv[4]; float ss = 0.f;
#pragma unroll
        for (int i = 0; i < 4; ++i) { const u32x2 raw = *(const u32x2*)(y + i * 256 + lane * 4); yv[i] = (f32x4){bflo(raw.x), bfhi(raw.x), bflo(raw.y), bfhi(raw.y)};
            ss += yv[i][0] * yv[i][0] + yv[i][1] * yv[i][1] + yv[i][2] * yv[i][2] + yv[i][3] * yv[i][3]; }
        ss = wave_sum(ss);
        const float rstd = rsqrtf(ss * (1.0f / D) + EPS);
#pragma unroll
        for (int i = 0; i < 4; ++i) { const f32x4 g = *(const f32x4*)(gate + i * 256 + lane * 4), gp = *(const f32x4*)(gpost + i * 256 + lane * 4);
            v[i] = v[i] + (w * g) * ((yv[i] * rstd) * gp); }
        if (xdst) {
#pragma unroll
            for (int i = 0; i < 4; ++i) *(f32x4*)(xdst + i * 256 + lane * 4) = v[i];
        }
    }
    if (hdst) {
        float ss = 0.f;
#pragma unroll
        for (int i = 0; i < 4; ++i) ss += v[i][0] * v[i][0] + v[i][1] * v[i][1] + v[i][2] * v[i][2] + v[i][3] * v[i][3];
        ss = wave_sum(ss);
        const float rstd = rsqrtf(ss * (1.0f / D) + EPS);
#pragma unroll
        for (int i = 0; i < 4; ++i) { const f32x4 g = *(const f32x4*)(gpre + i * 256 + lane * 4), sh = *(const f32x4*)(shift + i * 256 + lane * 4), sc = *(const f32x4*)(scale + i * 256 + lane * 4);
            const f32x4 h = ((v[i] * rstd) * g) * (1.0f + sc) + sh;
            u32x2 o; o.x = cvt_pk_bf16(h[0], h[1]); o.y = cvt_pk_bf16(h[2], h[3]);
            *(u32x2*)(hdst + i * 256 + lane * 4) = o; }
    }
}

template <bool HASY, bool HASH, bool SRCBF, int XMODE>
__device__ __forceinline__ void rows_phase(const float* mod, int r0, int r1, const float* srcLat, const float* srcCtx, const bf16_t* srcB, const bf16_t* ybuf, float w, int gate_j,
                                           const float* gpost, void* xdst, const float* gpre, int shift_j, bf16_t* hdst, int lane) {
    f32x4 PA[4], PB[4], PC[4];
    f32x4 cv[4], nv[4]; u32x2 cy[4], ny[4];
    int curb = -1;
#define ROW_LOAD(V, Y, r) do { \
        if (SRCBF) { _Pragma("unroll") for (int i = 0; i < 4; ++i) { const u32x2 raw_ = *(const u32x2*)(srcB + (size_t)(r) * D + i * 256 + lane * 4); V[i] = (f32x4){bflo(raw_.x), bfhi(raw_.x), bflo(raw_.y), bfhi(raw_.y)}; } } \
        else { const float* sp_ = (r) < MLAT ? srcLat + (size_t)(r) * D : srcCtx + (size_t)((r) - MLAT) * D; \
            _Pragma("unroll") for (int i = 0; i < 4; ++i) V[i] = *(const f32x4*)(sp_ + i * 256 + lane * 4); } \
        if (HASY) { _Pragma("unroll") for (int i = 0; i < 4; ++i) Y[i] = *(const u32x2*)(ybuf + (size_t)(r) * D + i * 256 + lane * 4); } } while (0)
    ROW_LOAD(cv, cy, r0);
    f32x4 sxf[4]; u32x2 sxb[4], shb[4]; int rs = -1;
#define ROW_STORE() do { if (rs >= 0) { \
        if (HASY && XMODE == 2) { _Pragma("unroll") for (int i = 0; i < 4; ++i) *(f32x4*)((float*)xdst + (size_t)rs * D + i * 256 + lane * 4) = sxf[i]; } \
        if (HASY && XMODE == 1 && rs < MLAT) { _Pragma("unroll") for (int i = 0; i < 4; ++i) *(u32x2*)((bf16_t*)xdst + (size_t)rs * D + i * 256 + lane * 4) = sxb[i]; } \
        if (HASH) { _Pragma("unroll") for (int i = 0; i < 4; ++i) *(u32x2*)(hdst + (size_t)rs * D + i * 256 + lane * 4) = shb[i]; } } } while (0)
    for (int r = r0; r < r1; ++r) {
        ROW_STORE();
        if (r + 1 < r1) ROW_LOAD(nv, ny, r + 1);
        const int bb = r < MLAT ? (r >> 11) : 16;
        if (bb != curb) {
            curb = bb;
            const float* mr = mod + (size_t)bb * NMOD * D;
#pragma unroll
            for (int i = 0; i < 4; ++i) {
                const int cix = i * 256 + lane * 4;
                if (HASY) PA[i] = (*(const f32x4*)(mr + gate_j * D + cix) * w) * *(const f32x4*)(gpost + cix);
                if (HASH) { PB[i] = *(const f32x4*)(gpre + cix) * (1.0f + *(const f32x4*)(mr + (shift_j + 1) * D + cix)); PC[i] = *(const f32x4*)(mr + shift_j * D + cix); }
            }
        }
        if (HASY) {
            f32x4 yv[4]; float ss = 0.f;
#pragma unroll
            for (int i = 0; i < 4; ++i) { yv[i] = (f32x4){bflo(cy[i].x), bfhi(cy[i].x), bflo(cy[i].y), bfhi(cy[i].y)};
                ss += yv[i][0] * yv[i][0] + yv[i][1] * yv[i][1] + yv[i][2] * yv[i][2] + yv[i][3] * yv[i][3]; }
            ss = wave_sum(ss);
            const float rstd = rsqrtf(ss * (1.0f / D) + EPS);
#pragma unroll
            for (int i = 0; i < 4; ++i) cv[i] = cv[i] + PA[i] * (yv[i] * rstd);
            if (XMODE == 2) {
#pragma unroll
                for (int i = 0; i < 4; ++i) sxf[i] = cv[i];
            }
            if (XMODE == 1) {
#pragma unroll
                for (int i = 0; i < 4; ++i) { u32x2 o; o.x = cvt_pk_bf16(cv[i][0], cv[i][1]); o.y = cvt_pk_bf16(cv[i][2], cv[i][3]); sxb[i] = o;
                    if (r < MLAT) cv[i] = (f32x4){bflo(o.x), bfhi(o.x), bflo(o.y), bfhi(o.y)}; }
            }
        }
        if (HASH) {
            float ss = 0.f;
#pragma unroll
            for (int i = 0; i < 4; ++i) ss += cv[i][0] * cv[i][0] + cv[i][1] * cv[i][1] + cv[i][2] * cv[i][2] + cv[i][3] * cv[i][3];
            ss = wave_sum(ss);
            const float rstd = rsqrtf(ss * (1.0f / D) + EPS);
#pragma unroll
            for (int i = 0; i < 4; ++i) { const f32x4 h = (cv[i] * rstd) * PB[i] + PC[i];
                u32x2 o; o.x = cvt_pk_bf16(h[0], h[1]); o.y = cvt_pk_bf16(h[2], h[3]); shb[i] = o; }
        }
        rs = r;
#pragma unroll
        for (int i = 0; i < 4; ++i) { cv[i] = nv[i]; cy[i] = ny[i]; }
    }
    ROW_STORE();
#undef ROW_STORE
#undef ROW_LOAD
}

__device__ __forceinline__ void attn_item(const Params& p, int item, int wid, int lane) {
    const bf16_t* qbuf = (const bf16_t*)(p.ws + OFF_QBUF);
    const bf16_t* kall = (const bf16_t*)(p.ws + OFF_KALL);
    const bf16_t* vtall = (const bf16_t*)(p.ws + OFF_VT);
    bf16_t* oatt = (bf16_t*)(p.ws + OFF_OATT);
    const int qb = item & 15, kvh = (item >> 4) & 1, b = item >> 5;
    const int g = wid >> 1, qh = wid & 1, head = kvh * 4 + g, q0 = qb * 128 + qh * 64;
    const int fr = lane & 15, fq = lane >> 4;
    const bf16_t* Kp = kall + (size_t)(b * 2 + kvh) * 2304 * 64;
    const bf16_t* Vp = vtall + (size_t)(b * 2 + kvh) * 64 * 2304;
    bf16x8 qf[4][2];
#pragma unroll
    for (int qt = 0; qt < 4; ++qt)
#pragma unroll
        for (int kk = 0; kk < 2; ++kk) qf[qt][kk] = *(const bf16x8*)(qbuf + (size_t)(b * T + q0 + qt * 16 + fr) * 512 + head * 64 + kk * 32 + fq * 8);
    f32x4 o[4][4]; float mrun[4], lrun[4];
#pragma unroll
    for (int qt = 0; qt < 4; ++qt) { mrun[qt] = -1e30f; lrun[qt] = 0.f;
#pragma unroll
        for (int dt = 0; dt < 4; ++dt) o[qt][dt] = (f32x4){0.f, 0.f, 0.f, 0.f}; }
    const int kb_lo = q0 - 128 < 0 ? 0 : q0 - 128, kb_hi = q0 + 192 > T ? T : q0 + 192;
    const int nband = (kb_hi - kb_lo) >> 5;
#define AT_LOADK(itx) do { const int k0_ = (itx) < nband ? kb_lo + (itx) * 32 : T + ((itx) - nband) * 32; \
        _Pragma("unroll") for (int kt = 0; kt < 2; ++kt) _Pragma("unroll") for (int kk = 0; kk < 2; ++kk) kf[kt][kk] = *(const bf16x8*)(Kp + (size_t)(k0_ + kt * 16 + fr) * 64 + kk * 32 + fq * 8); } while (0)
    bf16x8 kf[2][2];
    AT_LOADK(0);
    for (int it = 0; it < nband + 8; ++it) {
        const bool band = it < nband;
        const int key0 = band ? kb_lo + it * 32 : T + (it - nband) * 32;
        bf16x8 vf[4];
#pragma unroll
        for (int dt = 0; dt < 4; ++dt) {
            const bf16_t* vp = Vp + (size_t)(dt * 16 + fr) * 2304 + key0 + fq * 4;
            const u32x2 lo = *(const u32x2*)vp, hi = *(const u32x2*)(vp + 16);
            u32x4 w; w.x = lo.x; w.y = lo.y; w.z = hi.x; w.w = hi.y;
            vf[dt] = __builtin_bit_cast(bf16x8, w);
        }
        f32x4 sc[4][2];
#pragma unroll
        for (int qt = 0; qt < 4; ++qt) {
            f32x4 s0 = (f32x4){0.f, 0.f, 0.f, 0.f}, s1 = (f32x4){0.f, 0.f, 0.f, 0.f};
            s0 = __builtin_amdgcn_mfma_f32_16x16x32_bf16(kf[0][0], qf[qt][0], s0, 0, 0, 0);
            s0 = __builtin_amdgcn_mfma_f32_16x16x32_bf16(kf[0][1], qf[qt][1], s0, 0, 0, 0);
            s1 = __builtin_amdgcn_mfma_f32_16x16x32_bf16(kf[1][0], qf[qt][0], s1, 0, 0, 0);
            s1 = __builtin_amdgcn_mfma_f32_16x16x32_bf16(kf[1][1], qf[qt][1], s1, 0, 0, 0);
            sc[qt][0] = s0; sc[qt][1] = s1;
        }
        { const int itn = it + 1 < nband + 8 ? it + 1 : it; AT_LOADK(itn); }
        float mx[4];
#pragma unroll
        for (int qt = 0; qt < 4; ++qt)
            mx[qt] = fmaxf(fmaxf(fmaxf(sc[qt][0][0], sc[qt][0][1]), fmaxf(sc[qt][0][2], sc[qt][0][3])), fmaxf(fmaxf(sc[qt][1][0], sc[qt][1][1]), fmaxf(sc[qt][1][2], sc[qt][1][3])));
        const bool needmask = band && (key0 - q0 < -65 || key0 - q0 > 97);
        if (needmask) {
            const int dbase = key0 + fq * 4 - (q0 + fr);
#pragma unroll
            for (int qt = 0; qt < 4; ++qt) {
#pragma unroll
                for (int r = 0; r < 4; ++r) {
                    const int d0 = dbase + r - qt * 16, d1 = d0 + 16;
                    sc[qt][0][r] = (d0 > 128 || d0 < -128) ? -1e30f : sc[qt][0][r];
                    sc[qt][1][r] = (d1 > 128 || d1 < -128) ? -1e30f : sc[qt][1][r];
                }
                mx[qt] = fmaxf(fmaxf(fmaxf(sc[qt][0][0], sc[qt][0][1]), fmaxf(sc[qt][0][2], sc[qt][0][3])), fmaxf(fmaxf(sc[qt][1][0], sc[qt][1][1]), fmaxf(sc[qt][1][2], sc[qt][1][3])));
            }
        }
        float t16[4];
#pragma unroll
        for (int qt = 0; qt < 4; ++qt) t16[qt] = __shfl_xor(mx[qt], 16);
#pragma unroll
        for (int qt = 0; qt < 4; ++qt) mx[qt] = fmaxf(mx[qt], t16[qt]);
#pragma unroll
        for (int qt = 0; qt < 4; ++qt) t16[qt] = __shfl_xor(mx[qt], 32);
        float alpha[4]; bool resc = false;
#pragma unroll
        for (int qt = 0; qt < 4; ++qt) {
            mx[qt] = fmaxf(mx[qt], t16[qt]);
            const float mn = fmaxf(mrun[qt], mx[qt]);
            alpha[qt] = __builtin_amdgcn_exp2f(mrun[qt] - mn);
            resc = resc || (mn != mrun[qt]);
            mrun[qt] = mn;
        }
        bf16x8 pb[4];
#pragma unroll
        for (int qt = 0; qt < 4; ++qt) {
            float pr[8];
#pragma unroll
            for (int r = 0; r < 4; ++r) { pr[r] = __builtin_amdgcn_exp2f(sc[qt][0][r] - mrun[qt]); pr[4 + r] = __builtin_amdgcn_exp2f(sc[qt][1][r] - mrun[qt]); }
            lrun[qt] = lrun[qt] * alpha[qt] + ((pr[0] + pr[1]) + (pr[2] + pr[3])) + ((pr[4] + pr[5]) + (pr[6] + pr[7]));
            u32x4 pw; pw.x = cvt_pk_bf16(pr[0], pr[1]); pw.y = cvt_pk_bf16(pr[2], pr[3]); pw.z = cvt_pk_bf16(pr[4], pr[5]); pw.w = cvt_pk_bf16(pr[6], pr[7]);
            pb[qt] = __builtin_bit_cast(bf16x8, pw);
        }
        if (__any(resc)) {
#pragma unroll
            for (int qt = 0; qt < 4; ++qt)
#pragma unroll
                for (int dt = 0; dt < 4; ++dt) o[qt][dt] *= alpha[qt];
        }
#pragma unroll
        for (int qt = 0; qt < 4; ++qt)
#pragma unroll
            for (int dt = 0; dt < 4; ++dt) o[qt][dt] = __builtin_amdgcn_mfma_f32_16x16x32_bf16(vf[dt], pb[qt], o[qt][dt], 0, 0, 0);
    }
#undef AT_LOADK
    const float sink = p.attn_sink[head];
#pragma unroll
    for (int qt = 0; qt < 4; ++qt) {
        float lt = lrun[qt]; lt += __shfl_xor(lt, 16); lt += __shfl_xor(lt, 32);
        lt += __builtin_amdgcn_exp2f(sink * 1.44269504f - mrun[qt]);
        const float inv = 1.0f / lt;
        bf16_t* dst = oatt + (size_t)(b * T + q0 + qt * 16 + fr) * 512 + head * 64 + fq * 4;
#pragma unroll
        for (int dt = 0; dt < 4; ++dt) { const f32x4 v = o[qt][dt] * inv; u32x2 w; w.x = cvt_pk_bf16(v[0], v[1]); w.y = cvt_pk_bf16(v[2], v[3]); *(u32x2*)(dst + dt * 16) = w; }
    }
}

constexpr int LQS = 0, LQT = 17408, LKT = 34816, LST = 52224, LKDT = 87040, LVT = 105472, LPP = 123904, LCUM = 133120, LDEC = 135168, LROPE = 131072, LXST = 139264;
__device__ __forceinline__ void hgrn_unit(const Params& p, int unit, LAS unsigned char* lds, int tid) {
    const int dir = unit & 1, h = (unit >> 1) & 3, b = unit >> 3;
    const int wid = tid >> 6, lane = tid & 63, fr = lane & 15, fq = lane >> 4;
    const bf16_t* hbuf = (const bf16_t*)(p.ws + OFF_HBUF);
    bf16_t* odir = (bf16_t*)(p.ws + OFF_ODIR) + (size_t)dir * MLAT * 512;
    LAS bf16_t* Lqs = (LAS bf16_t*)(lds + LQS); LAS bf16_t* Lqt = (LAS bf16_t*)(lds + LQT); LAS bf16_t* Lkt = (LAS bf16_t*)(lds + LKT);
    LAS bf16_t* Lst = (LAS bf16_t*)(lds + LST); LAS bf16_t* Lkdt = (LAS bf16_t*)(lds + LKDT); LAS bf16_t* Lvt = (LAS bf16_t*)(lds + LVT);
    LAS bf16_t* Lp = (LAS bf16_t*)(lds + LPP); LAS float* Lcum = (LAS float*)(lds + LCUM); LAS float* Ldec = (LAS float*)(lds + LDEC);
    const int d = tid & 127, tg = tid >> 7;
    const float* lbraw = dir ? p.lb_bwd : p.lb_fwd;
    const float lbv = 1.0f / (1.0f + __expf(lbraw[512 + h * 128 + d] - lbraw[h * 128 + d]));
    const int colF = (dir ? 1024 : 512) + h * 128 + d, colQ = h * 128 + d, colV = 1536 + h * 128 + d;
    f32x4 Sacc[8];
#pragma unroll
    for (int ei = 0; ei < 8; ++ei) Sacc[ei] = (f32x4){0.f, 0.f, 0.f, 0.f};
#define LDSBAR() do { asm volatile("s_waitcnt lgkmcnt(0)" ::: "memory"); __builtin_amdgcn_s_barrier(); asm volatile("" ::: "memory"); } while (0)
    bf16_t pz[16], pq[16], pv[16];
#define HG_LOAD(cn) do { const bool latn_ = (cn) >= 4; const int ccn_ = latn_ ? (cn) - 4 : (cn); const int rbn_ = latn_ ? b * T : MLAT + b * L; const int sln_ = latn_ ? T - 1 : L - 1; \
        _Pragma("unroll") for (int i = 0; i < 16; ++i) { const int tl_ = ccn_ * 64 + tg * 16 + i, tok_ = dir ? sln_ - tl_ : tl_; const bf16_t* rp_ = hbuf + (size_t)(rbn_ + tok_) * 2048; pz[i] = rp_[colF]; pv[i] = rp_[colV]; if (latn_) pq[i] = rp_[colQ]; } } while (0)
#pragma unroll
    for (int i = 0; i < 16; ++i) pq[i] = 0;
    HG_LOAD(0);
#pragma unroll
    for (int ei = 0; ei < 8; ++ei) { u32x2 z; z.x = 0u; z.y = 0u; *(LAS u32x2*)(Lst + (ei * 16 + fr) * 136 + wid * 16 + fq * 4) = z; }
    LDSBAR();
    for (int c = 0; c < 36; ++c) {
        const bool lat = c >= 4;
        const int cc = lat ? c - 4 : c;
        const int rowbase = lat ? b * T : MLAT + b * L;
        const int seglast = lat ? T - 1 : L - 1;
        float gp[16], kk[16];
#pragma unroll
        for (int i = 0; i < 16; ++i) {
            const float z = bf2f(pz[i]);
            const float f = lbv + (1.0f - lbv) * sigmoidf_(z);
            gp[i] = f; kk[i] = 1.0f - f;
        }
        { float run = gp[15];
#pragma unroll
          for (int i = 14; i >= 0; --i) { kk[i] *= run; run *= gp[i]; } }
#pragma unroll
        for (int i = 1; i < 16; ++i) gp[i] *= gp[i - 1];
        Lcum[tg * 128 + d] = __logf(gp[15]);
        LDSBAR();
        const float c0 = Lcum[d], c1 = Lcum[128 + d], c2 = Lcum[256 + d], c3 = Lcum[384 + d];
        const float off = tg == 0 ? 0.f : tg == 1 ? c0 : tg == 2 ? c0 + c1 : c0 + c1 + c2;
        const float mid = c0 + c1, tot = (c0 + c1) + (c2 + c3);
        const float e_off = __expf(off), e_om = __expf(off - mid), e_mo = __expf(mid - off), e_to = __expf(tot - off);
        const float rgl = __builtin_amdgcn_rcpf(gp[15]);
#define rg kk
#pragma unroll
        for (int i = 0; i < 16; ++i) kk[i] *= rgl;
        if (lat) {
#pragma unroll
            for (int i = 0; i < 16; ++i) {
                const int t = tg * 16 + i;
                const float qg = bf2f(pq[i]) * gp[i];
                Lqs[t * 136 + d] = f2bf(qg * e_off);
                Lqt[t * 136 + d] = f2bf(qg * e_om);
                Lkt[t * 136 + d] = f2bf(rg[i] * e_mo);
            }
        }
        {
            u32x4 w0, w1;
            w0.x = cvt_pk_bf16(rg[0] * e_to, rg[1] * e_to); w0.y = cvt_pk_bf16(rg[2] * e_to, rg[3] * e_to); w0.z = cvt_pk_bf16(rg[4] * e_to, rg[5] * e_to); w0.w = cvt_pk_bf16(rg[6] * e_to, rg[7] * e_to);
            w1.x = cvt_pk_bf16(rg[8] * e_to, rg[9] * e_to); w1.y = cvt_pk_bf16(rg[10] * e_to, rg[11] * e_to); w1.z = cvt_pk_bf16(rg[12] * e_to, rg[13] * e_to); w1.w = cvt_pk_bf16(rg[14] * e_to, rg[15] * e_to);
            *(LAS u32x4*)(Lkdt + d * 72 + tg * 16) = w0; *(LAS u32x4*)(Lkdt + d * 72 + tg * 16 + 8) = w1;
            if (tg == 0) Ldec[d] = __expf(tot);
        }
        {
            u32x4 w0, w1;
            w0.x = pv[0] | ((unsigned)pv[1] << 16); w0.y = pv[2] | ((unsigned)pv[3] << 16); w0.z = pv[4] | ((unsigned)pv[5] << 16); w0.w = pv[6] | ((unsigned)pv[7] << 16);
            w1.x = pv[8] | ((unsigned)pv[9] << 16); w1.y = pv[10] | ((unsigned)pv[11] << 16); w1.z = pv[12] | ((unsigned)pv[13] << 16); w1.w = pv[14] | ((unsigned)pv[15] << 16);
            *(LAS u32x4*)(Lvt + d * 72 + tg * 16) = w0; *(LAS u32x4*)(Lvt + d * 72 + tg * 16 + 8) = w1;
        }
        if (c + 1 < 36) HG_LOAD(c + 1);
        LDSBAR();
        if (lat) {
            const int ti = wid >> 1;
#pragma unroll
            for (int uu = 0; uu < 2; ++uu) {
                const int si = (wid & 1) * 2 + uu;
                f32x4 a = (f32x4){0.f, 0.f, 0.f, 0.f};
#pragma unroll
                for (int k4 = 0; k4 < 4; ++k4) {
                    const bf16x8 af = *(const LAS bf16x8*)(Lqt + (ti * 16 + fr) * 136 + k4 * 32 + fq * 8);
                    const bf16x8 bf = *(const LAS bf16x8*)(Lkt + (si * 16 + fr) * 136 + k4 * 32 + fq * 8);
                    a = __builtin_amdgcn_mfma_f32_16x16x32_bf16(af, bf, a, 0, 0, 0);
                }
                const int s = si * 16 + fr;
#pragma unroll
                for (int r = 0; r < 4; ++r) { const int t = ti * 16 + fq * 4 + r; const float v = (si <= ti && s <= t) ? a[r] : 0.f; Lp[t * 72 + s] = f2bf(v); }
            }
            LDSBAR();
#pragma unroll
            for (int uu = 0; uu < 4; ++uu) {
                const int ei = (wid & 1) * 4 + uu;
                f32x4 a = (f32x4){0.f, 0.f, 0.f, 0.f};
#pragma unroll
                for (int k4 = 0; k4 < 4; ++k4) {
                    const bf16x8 af = *(const LAS bf16x8*)(Lqs + (ti * 16 + fr) * 136 + k4 * 32 + fq * 8);
                    const bf16x8 bf = *(const LAS bf16x8*)(Lst + (ei * 16 + fr) * 136 + k4 * 32 + fq * 8);
                    a = __builtin_amdgcn_mfma_f32_16x16x32_bf16(af, bf, a, 0, 0, 0);
                }
#pragma unroll
                for (int k2 = 0; k2 < 2; ++k2) {
                    const bf16x8 af = *(const LAS bf16x8*)(Lp + (ti * 16 + fr) * 72 + k2 * 32 + fq * 8);
                    const bf16x8 bf = *(const LAS bf16x8*)(Lvt + (ei * 16 + fr) * 72 + k2 * 32 + fq * 8);
                    a = __builtin_amdgcn_mfma_f32_16x16x32_bf16(af, bf, a, 0, 0, 0);
                }
#pragma unroll
                for (int r = 0; r < 4; ++r) {
                    const int tl = cc * 64 + ti * 16 + fq * 4 + r, tok = dir ? seglast - tl : tl;
                    odir[(size_t)(rowbase + tok) * 512 + h * 128 + ei * 16 + fr] = f2bf(a[r]);
                }
            }
        }
        {
            const f32x4 dec = *(const LAS f32x4*)(Ldec + wid * 16 + fq * 4);
#pragma unroll
            for (int ei = 0; ei < 8; ++ei) {
                f32x4 a = Sacc[ei] * dec;
#pragma unroll
                for (int k2 = 0; k2 < 2; ++k2) {
                    const bf16x8 af = *(const LAS bf16x8*)(Lkdt + (wid * 16 + fr) * 72 + k2 * 32 + fq * 8);
                    const bf16x8 bf = *(const LAS bf16x8*)(Lvt + (ei * 16 + fr) * 72 + k2 * 32 + fq * 8);
                    a = __builtin_amdgcn_mfma_f32_16x16x32_bf16(af, bf, a, 0, 0, 0);
                }
                Sacc[ei] = a;
            }
        }
        LDSBAR();
#pragma unroll
        for (int ei = 0; ei < 8; ++ei) { u32x2 w; w.x = cvt_pk_bf16(Sacc[ei][0], Sacc[ei][1]); w.y = cvt_pk_bf16(Sacc[ei][2], Sacc[ei][3]);
            *(LAS u32x2*)(Lst + (ei * 16 + fr) * 136 + wid * 16 + fq * 4) = w; }
    }
    __syncthreads();
#undef HG_LOAD
#undef rg
}

#define XB_TMO      128
#define XB_XCNT(j)  (256  + 64 * (j))
#define XB_XSUB(j)  (1280 + 64 * (j))
#define XB_XGEN(j)  (2304 + 64 * (j))
#define XB_TOP      3328
#define XB_TOPGEN   3392
#define XCD_BAR_WORDS 3456
#define XB_SPIN_CAP (1u << 20)
__device__ __forceinline__ unsigned xb_ld(unsigned* p)              { return __hip_atomic_load(p, __ATOMIC_RELAXED, __HIP_MEMORY_SCOPE_AGENT); }
__device__ __forceinline__ unsigned xb_add(unsigned* p, unsigned v) { return __hip_atomic_fetch_add(p, v, __ATOMIC_RELAXED, __HIP_MEMORY_SCOPE_AGENT); }
__device__ __forceinline__ unsigned xb_xcc_id() { return (unsigned)__builtin_amdgcn_s_getreg((3 << 11) | 20) & 0xFu; }
#define XB_SPIN(cond, bar) do { unsigned _sp = 0; while (cond) { __builtin_amdgcn_s_sleep(1); \
    if ((++_sp & 255u) == 0u) { if (xb_ld(&(bar)[XB_TMO])) break; if (_sp > XB_SPIN_CAP) { atomicAdd(&(bar)[XB_TMO], 1u); break; } } } } while (0)
__device__ __forceinline__ void xcd_barrier_complete(unsigned* bar, unsigned x, unsigned& nloc, unsigned& nx) {
    const unsigned G = gridDim.x * gridDim.y * gridDim.z;
    unsigned sum, cnt, mine, sp = 0u;
    for (;;) {
        sum = 0u; cnt = 0u; mine = 0u;
#pragma unroll
        for (unsigned j = 0; j < 16; ++j) { const unsigned c = xb_ld(&bar[XB_XCNT(j)]); sum += c; cnt += (c > 0u) ? 1u : 0u; mine = (j == x) ? c : mine; }
        if (sum == G) break;
        __builtin_amdgcn_s_sleep(1);
        if ((++sp & 255u) == 0u) { if (xb_ld(&bar[XB_TMO])) break; if (sp > XB_SPIN_CAP) { atomicAdd(&bar[XB_TMO], 1u); break; } }
    }
    nloc = mine > 0u ? mine : 1u; nx = cnt > 0u ? cnt : 1u;
}
__device__ __forceinline__ void xcd_barrier(unsigned* bar, volatile LAS unsigned* st) {
    asm volatile("s_waitcnt vmcnt(0)" ::: "memory");
    __syncthreads();
    if (threadIdx.x == 0) {
        const unsigned x = xb_xcc_id();
        __builtin_amdgcn_s_waitcnt(0);
        unsigned nloc = st[0], nx = st[1];
        if (nloc == 0u) { xcd_barrier_complete(bar, x, nloc, nx); st[0] = nloc; st[1] = nx; }
        const unsigned old = xb_add(&bar[XB_XSUB(x)], 1u);
        const unsigned gen = old / nloc;
        if (old + 1u == (gen + 1u) * nloc) {
            __builtin_amdgcn_fence(__ATOMIC_RELEASE, "agent");
            asm volatile("s_waitcnt vmcnt(0)" ::: "memory");
            const unsigned og = xb_add(&bar[XB_TOP], 1u);
            const unsigned tg = og / nx;
            if (og + 1u == (tg + 1u) * nx) xb_add(&bar[XB_TOPGEN], 1u);
            else XB_SPIN(xb_ld(&bar[XB_TOPGEN]) == tg, bar);
            __builtin_amdgcn_fence(__ATOMIC_ACQUIRE, "agent");
            xb_add(&bar[XB_XGEN(x)], 1u);
            asm volatile("s_waitcnt vmcnt(0)" ::: "memory");
        } else {
            XB_SPIN(xb_ld(&bar[XB_XGEN(x)]) == gen, bar);
            __builtin_amdgcn_fence(__ATOMIC_ACQUIRE, "agent");
            asm volatile("s_waitcnt vmcnt(0)" ::: "memory");
        }
    }
    __syncthreads();
}

__global__ void __launch_bounds__(512, 2) mega(Params p, int ph_lo, int ph_hi) {
    extern __shared__ __attribute__((aligned(16))) unsigned char shm[];
    LAS unsigned char* lds = (LAS unsigned char*)shm;
    volatile LAS unsigned* xst = (volatile LAS unsigned*)(lds + LXST);
    unsigned* xbar = (unsigned*)(p.ws + OFF_BAR);
    if (threadIdx.x == 0) { xst[0] = 0u; xst[1] = 0u; }
    __syncthreads();
    if (ph_hi - ph_lo > 1 && threadIdx.x == 0) (void)xb_add(&xbar[XB_XCNT(xb_xcc_id())], 1u);
#ifndef PROBE_PH
#define PROBE_PH -1
#define PROBE_EXTRA 0
#endif
    for (int phi = ph_lo; phi < ph_hi + PROBE_EXTRA; ++phi) {
        const int ph = (PROBE_PH < 0 || phi <= PROBE_PH) ? phi : (phi <= PROBE_PH + PROBE_EXTRA ? PROBE_PH : phi - PROBE_EXTRA);
        int tid = threadIdx.x; asm volatile("" : "+v"(tid));
        int G = gridDim.x, c = blockIdx.x; asm volatile("" : "+s"(G), "+s"(c));
        unsigned char* ws = p.ws;
        const int wid = tid >> 6, lane = tid & 63;
        const float* mod = (const float*)(ws + OFF_MOD);
        switch (ph) {
        case 0: if (PH_ON(0)) {
            for (int it = c; it < 288 + 1; it += G) {
                if (it < 288) mod_partial_item(p, it, (LAS float*)lds, tid);
                else { for (int i = tid; i < 1024; i += 512) { const int pos = i >> 4, fi = i & 15; const float fr_ = powf(10000.0f, -(float)fi / 16.0f), ang = (float)pos * fr_;
                        ((float2*)(ws + OFF_ROPE))[i] = make_float2(cosf(ang), sinf(ang)); } }
            }
            __syncthreads();
            convert_tiles(p, ws, 0, 3968, c, G, (LAS float*)lds, tid);
        } break;
        case 1: if (PH_ON(1)) {
            const float* part = (const float*)(ws + OFF_PART);
            for (int i = c * 512 + tid; i < 17 * NMOD * D; i += G * 512) {
                const int n = i % (NMOD * D);
                float s = p.b_ada[n];
#pragma unroll
                for (int ks = 0; ks < 16; ++ks) s += part[(size_t)ks * 17 * NMOD * D + i];
                ((float*)(ws + OFF_MOD))[i] = s;
            }
        } break;
        case 2: if (PH_ON(2)) {
            const int gw = c * 8 + wid, rpw = MALL / (G * 8);
            rows_phase<false, true, false, 0>(mod, gw * rpw, gw * rpw + rpw, p.x, p.ctx, (const bf16_t*)p.out, (const bf16_t*)(ws + OFF_Y), 0.f, 0, p.norm_post, p.out, p.norm_pre, 0, (bf16_t*)(ws + OFF_HA), lane);
        } break;
        case 3: case 13: if (PH_ON(3)) {
            const bool second = ph == 13;
            RectOrder S; S.A = (const char*)(ws + OFF_HA); S.B = (const char*)(ws + OFF_WFFN_IN); S.K = D; S.nM = second ? 128 : 144; S.nN = 22; S.nwg = S.nM * S.nN; S.G = G; S.c = c; S.pm0 = 0;
            EpiSwiglu E; E.act = (bf16_t*)(ws + OFF_ACT);
            gemm_phase(lds, D, S, E, tid);
        } break;
        case 4: case 5: case 11: case 14: if (PH_ON(4)) {
            RectOrder S; S.G = G; S.c = c; S.nN = 4; S.pm0 = 0; int K; bool dogemm = true;
            if (ph == 11) { S.A = (const char*)(ws + OFF_U); S.B = (const char*)(ws + OFF_WOUT); K = D; S.nM = 128; }
            else { S.A = (const char*)(ws + OFF_ACT); S.B = (const char*)(ws + OFF_WFFN_OUT); K = DFF; S.nM = 128; }
            if (ph == 5) {
                if (c >= 64) {
                    dogemm = false;
                    const int nw = (G - 64) * 8, gw = (c - 64) * 8 + wid, rpw = (MLAT + nw - 1) / nw;
                    const int r0 = gw * rpw, r1 = r0 + rpw < MLAT ? r0 + rpw : MLAT;
                    if (r0 < MLAT) rows_phase<true, true, false, 1>(mod, r0, r1, p.x, p.ctx, (const bf16_t*)p.out, (const bf16_t*)(ws + OFF_Y), 0.5f, 2, p.norm_post, p.out, p.norm_pre + D, 3, (bf16_t*)(ws + OFF_HA), lane);
                } else { S.nM = 16; S.pm0 = 128; S.G = 64; }
            }
            S.K = K; S.nwg = S.nM * S.nN;
            if (dogemm) {
                EpiBf16 E; E.C = (bf16_t*)(ws + OFF_Y); E.ldc = D;
                gemm_phase(lds, K, S, E, tid);
            }
        } break;
        case 6: if (PH_ON(5)) {
            const int gw = c * 8 + wid, rpw = MCTX / (G * 8);
            rows_phase<true, true, false, 0>(mod, MLAT + gw * rpw, MLAT + gw * rpw + rpw, p.x, p.ctx, (const bf16_t*)p.out, (const bf16_t*)(ws + OFF_Y), 0.5f, 2, p.norm_post, p.out, p.norm_pre + D, 3, (bf16_t*)(ws + OFF_HA), lane);
        } break;
        case 7: if (PH_ON(6)) {
            MixOrder S; S.A = (const char*)(ws + OFF_HA); S.B = (const char*)(ws + OFF_WMIX); S.G = G; S.c = c;
            EpiMixIn E; E.qbuf = (bf16_t*)(ws + OFF_QBUF); E.kall = (bf16_t*)(ws + OFF_KALL); E.vt = (bf16_t*)(ws + OFF_VT); E.hbuf = (bf16_t*)(ws + OFF_HBUF); E.gbuf = (bf16_t*)(ws + OFF_GBUF);
            ((LAS f32x4*)(lds + 131072))[tid] = ((const f32x4*)(ws + OFF_ROPE))[tid];
            __syncthreads();
            E.rope = (const LAS float2*)(lds + 131072);
            gemm_phase(lds, D, S, E, tid);
        } break;
        case 8: if (PH_ON(7)) {
            const int half = G >> 1;
#ifndef REP_HGRN
#define REP_HGRN 1
#define REP_ATTN 1
#endif
            if (c < half) { for (int rep = 0; rep < REP_HGRN; ++rep) for (int it = c; it < 128; it += half) hgrn_unit(p, it, lds, tid); }
            else { int tid2 = tid; asm volatile("" : "+v"(tid2));
                for (int rep = 0; rep < REP_ATTN; ++rep) for (int it = c - half; it < 512; it += G - half) attn_item(p, it, tid2 >> 6, tid2 & 63);
                __syncthreads();
                convert_tiles(p, ws, 1, 2112, c - half, G - half, (LAS float*)lds, tid); }
        } break;
        case 9: if (PH_ON(8)) {
            const bf16_t* of = (const bf16_t*)(ws + OFF_ODIR); const bf16_t* ob = of + (size_t)MLAT * 512;
            const bf16_t* gb = (const bf16_t*)(ws + OFF_GBUF); bf16_t* orr = (bf16_t*)(ws + OFF_OR);
            for (int r = c * 8 + wid; r < MLAT; r += G * 8) {
                const u32x4 a = *(const u32x4*)(of + (size_t)r * 512 + lane * 8), bq = *(const u32x4*)(ob + (size_t)r * 512 + lane * 8);
                const u32x4 gq = *(const u32x4*)(gb + (size_t)r * 2560 + lane * 8);
                float v[8]; float ss = 0.f;
#pragma unroll
                for (int q = 0; q < 4; ++q) { v[q * 2] = bflo(a[q]) + bflo(bq[q]); v[q * 2 + 1] = bfhi(a[q]) + bfhi(bq[q]); ss += v[q * 2] * v[q * 2] + v[q * 2 + 1] * v[q * 2 + 1]; }
                ss = wave_sum(ss);
                const float rstd = rsqrtf(ss * (1.0f / 512.0f) + EPS);
                const f32x4 g0 = *(const f32x4*)(p.hgrn_norm + lane * 8), g1 = *(const f32x4*)(p.hgrn_norm + lane * 8 + 4);
                float o[8];
#pragma unroll
                for (int q = 0; q < 4; ++q) {
                    const float h0 = bflo(gq[q]), h1 = bfhi(gq[q]);
                    const float gg0 = q < 2 ? g0[q * 2] : g1[q * 2 - 4], gg1 = q < 2 ? g0[q * 2 + 1] : g1[q * 2 - 3];
                    o[q * 2] = v[q * 2] * rstd * gg0 * siluf_(h0); o[q * 2 + 1] = v[q * 2 + 1] * rstd * gg1 * siluf_(h1);
                }
                u32x4 w; w.x = cvt_pk_bf16(o[0], o[1]); w.y = cvt_pk_bf16(o[2], o[3]); w.z = cvt_pk_bf16(o[4], o[5]); w.w = cvt_pk_bf16(o[6], o[7]);
                *(u32x4*)(orr + (size_t)r * 512 + lane * 8) = w;
            }
            __syncthreads();
        } break;
        case 10: if (PH_ON(9)) {
            MergeOrder S; S.A0 = (const char*)(ws + OFF_OATT); S.B0 = (const char*)(ws + OFF_WOA); S.A1 = (const char*)(ws + OFF_OR); S.B1 = (const char*)(ws + OFF_WOH); S.G = G; S.c = c;
            EpiMerge E; E.gbuf = (const bf16_t*)(ws + OFF_GBUF); E.U = (bf16_t*)(ws + OFF_U);
            gemm_phase(lds, 512, S, E, tid);
        } break;
        case 12: if (PH_ON(11)) {
            const int gw = c * 8 + wid, rpw = MLAT / (G * 8);
            rows_phase<true, true, true, 1>(mod, gw * rpw, gw * rpw + rpw, p.x, p.ctx, (const bf16_t*)p.out, (const bf16_t*)(ws + OFF_Y), 1.0f, 5, p.norm_post + D, ws + OFF_X2, p.norm_pre + 2 * D, 6, (bf16_t*)(ws + OFF_HA), lane);
        } break;
        case 15: if (PH_ON(14)) {
            const int gw = c * 8 + wid, rpw = MLAT / (G * 8);
            rows_phase<true, false, true, 2>(mod, gw * rpw, gw * rpw + rpw, p.x, p.ctx, (const bf16_t*)(ws + OFF_X2), (const bf16_t*)(ws + OFF_Y), 0.5f, 8, p.norm_post + 2 * D, p.out, p.norm_pre, 0, (bf16_t*)(ws + OFF_HA), lane);
        } break;
        default: break;
        }
        if (phi + 1 < ph_hi + PROBE_EXTRA) xcd_barrier(xbar, xst);
    }
}

extern "C" void kernel_launch(void* const* d_in, const int* in_sizes, int n_in, void* d_out, int out_size, void* d_ws, size_t ws_size, hipStream_t stream) {
    static int grid_blocks = 0;
    if (!grid_blocks) {
        hipFuncSetAttribute((const void*)mega, hipFuncAttributeMaxDynamicSharedMemorySize, LDS_BYTES);
        int dev = 0, cus = 0, per_cu = 0;
        hipGetDevice(&dev);
        hipDeviceGetAttribute(&cus, hipDeviceAttributeMultiprocessorCount, dev);
        hipOccupancyMaxActiveBlocksPerMultiprocessor(&per_cu, mega, 512, LDS_BYTES);
        if (per_cu < 1) per_cu = 1;
        if (per_cu > 1) per_cu = 1;
        grid_blocks = cus * per_cu;
        if (grid_blocks > 256) grid_blocks = 256;
    }
    Params p{};
    const float** pp = (const float**)&p;
    for (int i = 0; i < 20; ++i) pp[i] = (const float*)d_in[i];
    p.out = (float*)d_out; p.ws = (unsigned char*)d_ws;
    hipMemsetAsync((unsigned char*)d_ws + OFF_BAR, 0, XCD_BAR_WORDS * sizeof(unsigned), stream);
#if MULTI_LAUNCH
    for (int ph = 0; ph < NPH; ++ph) { hipLaunchKernelGGL(mega, dim3(grid_blocks), dim3(512), LDS_BYTES, stream, p, ph, ph + 1); }
#else
    hipLaunchKernelGGL(mega, dim3(grid_blocks), dim3(512), LDS_BYTES, stream, p, 0, NPH);
#endif
}
```

```cpp
#include <hip/hip_runtime.h>
#include <hip/hip_cooperative_groups.h>
#include <cstdio>
namespace cg = cooperative_groups;

#ifndef MULTI_LAUNCH
#define MULTI_LAUNCH 0
#endif

#ifndef PHASE_MASK
#define PHASE_MASK 0xffff
#endif
#define PH_ON(n) (((PHASE_MASK) >> (n)) & 1)
#define LAS __attribute__((address_space(3)))
typedef unsigned short bf16_t;
typedef short bf16x8 __attribute__((ext_vector_type(8)));
typedef float f32x4 __attribute__((ext_vector_type(4)));
typedef unsigned u32x4 __attribute__((ext_vector_type(4)));
typedef unsigned u32x2 __attribute__((ext_vector_type(2)));

constexpr int D = 1024, NB = 16, T = 2048, L = 256, MLAT = NB * T, MCTX = NB * L, MALL = MLAT + MCTX;
constexpr int DFF = 2816, INW = 5376, NMOD = 9;
constexpr float EPS = 1e-6f;
constexpr int NPH = 16;
constexpr int LDS_BYTES = 139264 + 16;

constexpr size_t MiB = 1u << 20;
constexpr size_t OFF_WFFN_IN = 0;
constexpr size_t OFF_WFFN_OUT = 11 * MiB;
constexpr size_t OFF_WMIX = 11 * MiB + 5632 * 1024;
constexpr size_t OFF_WOA = 27 * MiB;
constexpr size_t OFF_WOH = 28 * MiB;
constexpr size_t OFF_WOUT = 29 * MiB;
constexpr size_t OFF_MOD = 31 * MiB;
constexpr size_t OFF_ROPE = 31 * MiB + 640 * 1024;
constexpr size_t OFF_BAR = 32 * MiB;
constexpr size_t OFF_HA = 33 * MiB;
constexpr size_t OFF_ODIR = 33 * MiB;
constexpr size_t OFF_Y = 105 * MiB;
constexpr size_t OFF_QBUF = 105 * MiB;
constexpr size_t OFF_OR = 105 * MiB;
constexpr size_t OFF_KALL = 137 * MiB;
constexpr size_t OFF_VT = 146 * MiB;
constexpr size_t OFF_OATT = 155 * MiB;
constexpr size_t OFF_ACT = 177 * MiB;
constexpr size_t OFF_PART = 177 * MiB;
constexpr size_t OFF_HBUF = 187 * MiB;
constexpr size_t OFF_U = 187 * MiB;
constexpr size_t OFF_GBUF = 331 * MiB;
constexpr size_t OFF_X2 = 400 * MiB;

struct Params {
    const float *x, *c, *ctx, *c_ctx, *w_ada, *b_ada, *norm_pre, *norm_post, *ffn1_w_in, *ffn1_w_out, *ffn2_w_in, *ffn2_w_out,
        *mix_w_in, *attn_sink, *lb_fwd, *lb_bwd, *hgrn_norm, *w_o_attn, *w_o_hgrn, *w_out;
    float* out;
    unsigned char* ws;
};

typedef __bf16 bf16x2_t __attribute__((ext_vector_type(2)));
__device__ __forceinline__ unsigned cvt_pk_bf16(float lo, float hi) { bf16x2_t v; v[0] = (__bf16)lo; v[1] = (__bf16)hi; return __builtin_bit_cast(unsigned, v); }
__device__ __forceinline__ bf16_t f2bf(float f) { return __builtin_bit_cast(bf16_t, (__bf16)f); }
__device__ __forceinline__ float bf2f(bf16_t b) { return __uint_as_float(((unsigned)b) << 16); }
__device__ __forceinline__ float bflo(unsigned w) { return __uint_as_float(w << 16); }
__device__ __forceinline__ float bfhi(unsigned w) { return __uint_as_float(w & 0xffff0000u); }
__device__ __forceinline__ float sigmoidf_(float v) { return __builtin_amdgcn_rcpf(1.0f + __builtin_amdgcn_exp2f(v * -1.44269504f)); }
__device__ __forceinline__ float siluf_(float v) { return v * __builtin_amdgcn_rcpf(1.0f + __builtin_amdgcn_exp2f(v * -1.44269504f)); }
__device__ __forceinline__ float wave_sum(float v) {
#pragma unroll
    for (int o = 32; o >= 1; o >>= 1) v += __shfl_xor(v, o);
    return v;
}

constexpr int BM = 256, BK = 64, HALF = 128, HTB = HALF * BK * 2, NXCD = 8, WGM = 8;
__device__ __forceinline__ int lds_byte(int r, int c) { const int st = (r >> 4) * 2 + (c >> 5), rr = r & 15, cc = c & 31, ob = rr * 64 + cc * 2; return st * 1024 + (ob ^ (((ob >> 9) & 1) << 5)); }
__device__ __forceinline__ void stage_rc(int b, int& R, int& C) { const int st = b / 1024, sb = b % 1024, swz = sb ^ (((sb >> 9) & 1) << 5); R = (st >> 1) * 16 + swz / 64; C = (st & 1) * 32 + (swz % 64) / 2; }
__device__ __forceinline__ int perm32(int rho) { const int n = rho >> 4, i = rho & 15; return 8 * (i >> 2) + 4 * n + (i & 3); }

struct Unit { int pm, pn, part; };

__device__ __forceinline__ void rect_map(int Lidx, int nwg, int nM, int nN, int& pm, int& pn) {
    int wgid = Lidx;
    { const int q = nwg / NXCD, r = nwg % NXCD, xcd = wgid % NXCD, off = wgid / NXCD; wgid = (xcd < r ? xcd * (q + 1) : r * (q + 1) + (xcd - r) * q) + off; }
    const int nig = WGM * nN, gid = wgid / nig, fm = gid * WGM, gsz = (nM - fm) < WGM ? (nM - fm) : WGM;
    pm = fm + ((wgid % nig) % gsz); pn = (wgid % nig) / gsz;
}

struct RectOrder {
    const char *A, *B; int K, nM, nN, nwg, G, c, pm0;
    __device__ __forceinline__ bool next(int i, Unit& u) const {
        const int Lidx = i * G + c; if (Lidx >= nwg) return false;
        rect_map(Lidx, nwg, nM, nN, u.pm, u.pn); u.pm += pm0; u.part = 0; return true;
    }
    __device__ __forceinline__ const char* aptr(const Unit& u) const { return A + (size_t)u.pm * 512 * K; }
    __device__ __forceinline__ const char* bptr(const Unit& u) const { return B + (size_t)u.pn * 512 * K; }
};
struct MixOrder {
    const char *A, *B; int G, c;
    __device__ __forceinline__ bool next(int i, Unit& u) const {
        const int Lidx = i * G + c; if (Lidx >= 2800) return false;
        if (Lidx < 2688) rect_map(Lidx, 2688, 128, 21, u.pm, u.pn);
        else { const int j = Lidx - 2688, cs = j >> 4; u.pm = 128 + (j & 15); u.pn = cs == 0 ? 2 : 4 + cs; }
        u.part = 0; return true;
    }
    __device__ __forceinline__ const char* aptr(const Unit& u) const { return A + (size_t)u.pm * 512 * 1024; }
    __device__ __forceinline__ const char* bptr(const Unit& u) const { return B + (size_t)u.pn * 512 * 1024; }
};
struct MergeOrder {
    const char *A0, *B0, *A1, *B1; int G, c;
    __device__ __forceinline__ bool next(int i, Unit& u) const {
        const int Lidx = (i >> 1) * G + c; if (Lidx >= 512) return false;
        rect_map(Lidx, 512, 128, 4, u.pm, u.pn); u.part = i & 1; return true;
    }
    __device__ __forceinline__ const char* aptr(const Unit& u) const { return (u.part ? A1 : A0) + (size_t)u.pm * 512 * 512; }
    __device__ __forceinline__ const char* bptr(const Unit& u) const { return (u.part ? B1 : B0) + (size_t)u.pn * 512 * 512; }
};

typedef f32x4 Acc[2][2][4][2];

struct EpiSwiglu {
    static constexpr bool PERM = true;
    bf16_t* act;
    __device__ __forceinline__ bool operator()(Acc& acc, const Unit& u, int wr, int wc, int fr, int fq) const {
#pragma unroll
        for (int ai = 0; ai < 2; ++ai)
#pragma unroll
            for (int m = 0; m < 4; ++m) {
                const int r = u.pm * BM + ai * HALF + wr * 64 + m * 16 + fr;
                float v[8];
#pragma unroll
                for (int n = 0; n < 2; ++n)
#pragma unroll
                    for (int j = 0; j < 4; ++j) { const float g = acc[ai][0][m][n][j], up = acc[ai][1][m][n][j]; v[n * 4 + j] = (g * up) * __builtin_amdgcn_rcpf(1.0f + __builtin_amdgcn_exp2f(g * -1.44269504f)); }
                u32x4 w; w.x = cvt_pk_bf16(v[0], v[1]); w.y = cvt_pk_bf16(v[2], v[3]); w.z = cvt_pk_bf16(v[4], v[5]); w.w = cvt_pk_bf16(v[6], v[7]);
                *(u32x4*)(act + (size_t)r * DFF + u.pn * 128 + wc * 32 + fq * 8) = w;
            }
        return false;
    }
};
struct EpiBf16 {
    static constexpr bool PERM = true;
    bf16_t* C; int ldc;
    __device__ __forceinline__ bool operator()(Acc& acc, const Unit& u, int wr, int wc, int fr, int fq) const {
#pragma unroll
        for (int ai = 0; ai < 2; ++ai)
#pragma unroll
            for (int m = 0; m < 4; ++m) {
                const int r = u.pm * BM + ai * HALF + wr * 64 + m * 16 + fr;
#pragma unroll
                for (int bj = 0; bj < 2; ++bj) {
                    const f32x4 v0 = acc[ai][bj][m][0], v1 = acc[ai][bj][m][1];
                    u32x4 w; w.x = cvt_pk_bf16(v0[0], v0[1]); w.y = cvt_pk_bf16(v0[2], v0[3]); w.z = cvt_pk_bf16(v1[0], v1[1]); w.w = cvt_pk_bf16(v1[2], v1[3]);
                    *(u32x4*)(C + (size_t)r * ldc + u.pn * BM + bj * HALF + wc * 32 + fq * 8) = w;
                }
            }
        return false;
    }
};
struct EpiMerge {
    static constexpr bool PERM = true;
    const bf16_t* gbuf; bf16_t* U;
    __device__ __forceinline__ bool operator()(Acc& acc, const Unit& u, int wr, int wc, int fr, int fq) const {
        const bool first = u.part == 0;
        const int colb = u.pn * BM + wc * 32 + fq * 8;
        const int rowb = u.pm * BM + wr * 64 + fr;
        u32x4 ghc[2], gac[2], ghn[2], gan[2];
#define MG_LOAD(GH, GA, it) do { const int r_ = rowb + ((it) >> 2) * HALF + ((it) & 3) * 16; \
        _Pragma("unroll") for (int bj = 0; bj < 2; ++bj) { GH[bj] = *(const u32x4*)(gbuf + (size_t)r_ * 2560 + 1536 + colb + bj * HALF); \
            if (first) GA[bj] = *(const u32x4*)(gbuf + (size_t)r_ * 2560 + 512 + colb + bj * HALF); else GA[bj] = GH[bj]; } } while (0)
        MG_LOAD(ghc, gac, 0);
#pragma unroll
        for (int it = 0; it < 8; ++it) {
            const int ai = it >> 2, m = it & 3;
            if (it < 7) MG_LOAD(ghn, gan, it + 1);
            const int r = rowb + ai * HALF + m * 16;
#pragma unroll
            for (int bj = 0; bj < 2; ++bj) {
                if (first) {
#pragma unroll
                    for (int q = 0; q < 4; ++q) {
                        const float a0 = bflo(gac[bj][q]), a1 = bfhi(gac[bj][q]), h0 = bflo(ghc[bj][q]), h1 = bfhi(ghc[bj][q]);
                        const float r0 = (1.0f + __builtin_amdgcn_exp2f(h0 * -1.44269504f)) * __builtin_amdgcn_rcpf(1.0f + __builtin_amdgcn_exp2f(a0 * -1.44269504f));
                        const float r1 = (1.0f + __builtin_amdgcn_exp2f(h1 * -1.44269504f)) * __builtin_amdgcn_rcpf(1.0f + __builtin_amdgcn_exp2f(a1 * -1.44269504f));
                        acc[ai][bj][m][q >> 1][(q & 1) * 2] *= r0; acc[ai][bj][m][q >> 1][(q & 1) * 2 + 1] *= r1;
                    }
                } else {
                    float v[8];
#pragma unroll
                    for (int q = 0; q < 4; ++q) {
                        const float h0 = bflo(ghc[bj][q]), h1 = bfhi(ghc[bj][q]);
                        v[q * 2] = acc[ai][bj][m][q >> 1][(q & 1) * 2] * sigmoidf_(h0); v[q * 2 + 1] = acc[ai][bj][m][q >> 1][(q & 1) * 2 + 1] * sigmoidf_(h1);
                    }
                    u32x4 w; w.x = cvt_pk_bf16(v[0], v[1]); w.y = cvt_pk_bf16(v[2], v[3]); w.z = cvt_pk_bf16(v[4], v[5]); w.w = cvt_pk_bf16(v[6], v[7]);
                    *(u32x4*)(U + (size_t)r * D + colb + bj * HALF) = w;
                }
            }
#pragma unroll
            for (int bj = 0; bj < 2; ++bj) { ghc[bj] = ghn[bj]; gac[bj] = gan[bj]; }
        }
#undef MG_LOAD
        return first;
    }
};
struct EpiMixIn {
    static constexpr bool PERM = true;
    bf16_t *qbuf, *kall, *vt, *hbuf, *gbuf; const LAS float2* rope;
    __device__ __forceinline__ bool operator()(Acc& acc, const Unit& u, int wr, int wc, int fr, int fq) const {
        const int pn = u.pn;
        const int rowb = u.pm * BM + wr * 64 + fr;
        if (pn <= 2) {
            const bool lat = u.pm < 128;
#pragma unroll
            for (int ai = 0; ai < 2; ++ai) {
            float2 cs[4][4];
#pragma unroll
            for (int it = 0; it < 4; ++it) {
                const int r = rowb + ai * HALF + it * 16;
                const int t = r & (T - 1), pos = (wc & 1) ? (t & 63) : (t >> 6);
#pragma unroll
                for (int j = 0; j < 4; ++j) { const LAS float* rp_ = (const LAS float*)(rope + pos * 16 + fq * 4 + j); cs[it][j] = lat ? make_float2(rp_[0], rp_[1]) : make_float2(1.0f, 0.0f); }
            }
#pragma unroll
            for (int it = 0; it < 4; ++it) {
                const int m = it;
                const int r = rowb + ai * HALF + m * 16;
                if (pn < 2) {
#pragma unroll
                    for (int bj = 0; bj < 2; ++bj) {
                        const f32x4 x1 = acc[ai][bj][m][0], x2 = acc[ai][bj][m][1];
                        float o1[4], o2[4];
#pragma unroll
                        for (int j = 0; j < 4; ++j) { o1[j] = (x1[j] * cs[it][j].x - x2[j] * cs[it][j].y) * 0.18033688f; o2[j] = (x1[j] * cs[it][j].y + x2[j] * cs[it][j].x) * 0.18033688f; }
                        bf16_t* dst = qbuf + (size_t)r * 512 + pn * 256 + bj * 128 + wc * 32 + fq * 4;
                        u32x2 w0, w1; w0.x = cvt_pk_bf16(o1[0], o1[1]); w0.y = cvt_pk_bf16(o1[2], o1[3]); w1.x = cvt_pk_bf16(o2[0], o2[1]); w1.y = cvt_pk_bf16(o2[2], o2[3]);
                        *(u32x2*)dst = w0; *(u32x2*)(dst + 16) = w1;
                    }
                } else {
                    const int b = lat ? (r >> 11) : ((r - MLAT) >> 8);
                    const int tpos = lat ? (r & (T - 1)) : (T + ((r - MLAT) & (L - 1)));
                    const int kvh = wc >> 1;
                    f32x4 x1 = acc[ai][0][m][0], x2 = acc[ai][0][m][1];
#pragma unroll
                    for (int j = 0; j < 4; ++j) { const float a = x1[j], bb = x2[j]; x1[j] = a * cs[it][j].x - bb * cs[it][j].y; x2[j] = a * cs[it][j].y + bb * cs[it][j].x; }
                    bf16_t* kd = kall + ((size_t)(b * 2 + kvh) * 2304 + tpos) * 64 + (wc & 1) * 32 + fq * 4;
                    u32x2 w0, w1; w0.x = cvt_pk_bf16(x1[0], x1[1]); w0.y = cvt_pk_bf16(x1[2], x1[3]); w1.x = cvt_pk_bf16(x2[0], x2[1]); w1.y = cvt_pk_bf16(x2[2], x2[3]);
                    *(u32x2*)kd = w0; *(u32x2*)(kd + 16) = w1;
                    const f32x4 v1 = acc[ai][1][m][0], v2 = acc[ai][1][m][1];
                    bf16_t* vd = vt + ((size_t)(b * 2 + kvh) * 64 + (wc & 1) * 32 + fq * 8) * 2304 + tpos;
#pragma unroll
                    for (int j = 0; j < 4; ++j) { vd[(size_t)j * 2304] = f2bf(v1[j]); vd[(size_t)(j + 4) * 2304] = f2bf(v2[j]); }
                }
            }
            }
        } else if (pn <= 4) {
#pragma unroll
            for (int ai = 0; ai < 2; ++ai)
#pragma unroll
                for (int m = 0; m < 4; ++m) {
                    const int r = rowb + ai * HALF + m * 16;
                    bf16_t* dst = hbuf + (size_t)r * 2048 + (pn - 3) * 256;
#pragma unroll
                    for (int bj = 0; bj < 2; ++bj) {
                        const f32x4 v0 = acc[ai][bj][m][0], v1 = acc[ai][bj][m][1];
                        u32x4 w; w.x = cvt_pk_bf16(siluf_(v0[0]), siluf_(v0[1])); w.y = cvt_pk_bf16(siluf_(v0[2]), siluf_(v0[3]));
                        w.z = cvt_pk_bf16(siluf_(v1[0]), siluf_(v1[1])); w.w = cvt_pk_bf16(siluf_(v1[2]), siluf_(v1[3]));
                        *(u32x4*)(dst + bj * 128 + wc * 32 + fq * 8) = w;
                    }
                }
        } else {
#pragma unroll
            for (int ai = 0; ai < 2; ++ai)
#pragma unroll
                for (int m = 0; m < 4; ++m) {
                    const int r = rowb + ai * HALF + m * 16;
                    bf16_t* dst = pn < 11 ? hbuf + (size_t)r * 2048 + (pn - 3) * 256 : gbuf + (size_t)r * 2560 + (pn - 11) * 256;
#pragma unroll
                    for (int bj = 0; bj < 2; ++bj) {
                        const f32x4 v0 = acc[ai][bj][m][0], v1 = acc[ai][bj][m][1];
                        u32x4 w; w.x = cvt_pk_bf16(v0[0], v0[1]); w.y = cvt_pk_bf16(v0[2], v0[3]); w.z = cvt_pk_bf16(v1[0], v1[1]); w.w = cvt_pk_bf16(v1[2], v1[3]);
                        *(u32x4*)(dst + bj * 128 + wc * 32 + fq * 8) = w;
                    }
                }
        }
        return false;
    }
};

template <class Epi, class Sched>
__device__ __forceinline__ void gemm_phase(LAS unsigned char* lds, const int K, const Sched& S, const Epi& E, const int tid) {
    const int wid = __builtin_amdgcn_readfirstlane(tid >> 6), lane = tid & 63, wr = wid >> 2, wc = wid & 3, fr = lane & 15, fq = lane >> 4;
    const int nt = K / BK;
    unsigned voffA[2], voffB[2];
#pragma unroll
    for (int i = 0; i < 2; ++i) { int R, C; stage_rc(tid * 16 + i * 8192, R, C); const int Rb = Epi::PERM ? ((R & ~31) + perm32(R & 31)) : R;
        voffA[i] = (unsigned)(R * K + C) * 2u; voffB[i] = (unsigned)(Rb * K + C) * 2u; }
    const size_t kstep = (size_t)(BK * 2);
    const size_t hstep = (size_t)HALF * K * 2;
    const unsigned ldsw = (unsigned)wid * 1024u;
    const int aoff = lds_byte(wr * 64 + fr, fq * 8), boff = lds_byte(wc * 32 + fr, fq * 8);
#define PG8_SA(b, h) (((b) * 2 + (h)) * HTB)
#define PG8_SB(b, h) ((4 + (b) * 2 + (h)) * HTB)
#define PG8_STAGE(bufoff, gbase, voff) do { _Pragma("unroll") for (int _i = 0; _i < 2; ++_i) \
        __builtin_amdgcn_global_load_lds((const unsigned*)((const char*)(gbase) + (voff)[_i]), (LAS unsigned*)(lds + (bufoff) + ldsw + _i * 8192), 16, 0, 0); } while (0)
#define PG8_LDA(dst, b, h) do { _Pragma("unroll") for (int m = 0; m < 4; ++m) _Pragma("unroll") for (int k = 0; k < 2; ++k) dst[m][k] = *(const LAS bf16x8*)(lds + PG8_SA(b, h) + aoff + m * 2048 + k * 1024); } while (0)
#define PG8_LDB(dst, b, h) do { _Pragma("unroll") for (int n = 0; n < 2; ++n) _Pragma("unroll") for (int k = 0; k < 2; ++k) dst[n][k] = *(const LAS bf16x8*)(lds + PG8_SB(b, h) + boff + n * 2048 + k * 1024); } while (0)
#define PG8_MMA(ai, bj, At, Bt) do { __builtin_amdgcn_s_setprio(1); _Pragma("unroll") for (int m = 0; m < 4; ++m) _Pragma("unroll") for (int n = 0; n < 2; ++n) _Pragma("unroll") for (int k = 0; k < 2; ++k) \
        acc[ai][bj][m][n] = __builtin_amdgcn_mfma_f32_16x16x32_bf16(Bt[n][k], At[m][k], acc[ai][bj][m][n], 0, 0, 0); __builtin_amdgcn_s_setprio(0); } while (0)
#define PG8_WAIT_V(n) asm volatile("s_waitcnt vmcnt(" #n ")" ::: "memory")
#define PG8_WAIT_L(n) asm volatile("s_waitcnt lgkmcnt(" #n ")" ::: "memory")
#define PG8_BAR __builtin_amdgcn_s_barrier()
#define PG8_SCHED __builtin_amdgcn_sched_barrier(0)
    Unit cur, nxt; int ui = 0;
    if (!S.next(0, cur)) return;
    Acc acc;
#pragma unroll
    for (int a = 0; a < 2; ++a)
#pragma unroll
        for (int b = 0; b < 2; ++b)
#pragma unroll
            for (int m = 0; m < 4; ++m)
#pragma unroll
                for (int n = 0; n < 2; ++n) acc[a][b][m][n] = (f32x4){0.f, 0.f, 0.f, 0.f};
    bf16x8 At[4][2], B0[2][2], B1[2][2];
    const char* cA = S.aptr(cur); const char* cB = S.bptr(cur);
    PG8_STAGE(PG8_SB(0, 0), cB, voffB); PG8_STAGE(PG8_SA(0, 0), cA, voffA); PG8_STAGE(PG8_SB(0, 1), cB + hstep, voffB); PG8_STAGE(PG8_SA(0, 1), cA + hstep, voffA);
    if (wr == 1) PG8_BAR;
    PG8_WAIT_V(4); PG8_BAR;
    PG8_STAGE(PG8_SB(1, 0), cB + kstep, voffB); PG8_STAGE(PG8_SA(1, 0), cA + kstep, voffA); PG8_STAGE(PG8_SB(1, 1), cB + hstep + kstep, voffB);
    PG8_WAIT_V(6); PG8_BAR;
    for (;;) {
        const bool has_next = S.next(ui + 1, nxt);
        const char* nA = has_next ? S.aptr(nxt) : cA; const char* nB = has_next ? S.bptr(nxt) : cB;
        for (int t = 0; t < nt; t += 2) {
            const bool last = (t == nt - 2);
            const char* a1 = cA + (size_t)(t + 1) * kstep;
            const char* a2 = last ? nA : cA + (size_t)(t + 2) * kstep; const char* b2 = last ? nB : cB + (size_t)(t + 2) * kstep;
            const char* a3 = a2 + kstep; const char* b3 = b2 + kstep;
            PG8_LDB(B0, 0, 0); PG8_SCHED; PG8_LDA(At, 0, 0); PG8_STAGE(PG8_SA(1, 1), a1 + hstep, voffA);
            PG8_WAIT_L(8); PG8_BAR; PG8_WAIT_L(0); PG8_MMA(0, 0, At, B0); PG8_BAR; PG8_SCHED;
            PG8_LDB(B1, 0, 1); PG8_STAGE(PG8_SB(0, 0), b2, voffB);
            PG8_BAR; PG8_WAIT_L(0); PG8_MMA(0, 1, At, B1); PG8_BAR;
            PG8_LDA(At, 0, 1); PG8_STAGE(PG8_SA(0, 0), a2, voffA);
            PG8_BAR; PG8_WAIT_L(0); PG8_MMA(1, 0, At, B0); PG8_BAR; PG8_SCHED;
            PG8_STAGE(PG8_SB(0, 1), b2 + hstep, voffB);
            PG8_WAIT_V(6); PG8_BAR; PG8_MMA(1, 1, At, B1); PG8_BAR;
            PG8_LDB(B0, 1, 0); PG8_SCHED; PG8_LDA(At, 1, 0); PG8_STAGE(PG8_SA(0, 1), a2 + hstep, voffA);
            PG8_WAIT_L(8); PG8_BAR; PG8_WAIT_L(0); PG8_MMA(0, 0, At, B0); PG8_BAR; PG8_SCHED;
            PG8_LDB(B1, 1, 1); PG8_STAGE(PG8_SB(1, 0), b3, voffB);
            PG8_BAR; PG8_WAIT_L(0); PG8_MMA(0, 1, At, B1); PG8_BAR;
            PG8_LDA(At, 1, 1); PG8_STAGE(PG8_SA(1, 0), a3, voffA);
            PG8_BAR; PG8_WAIT_L(0); PG8_MMA(1, 0, At, B0); PG8_BAR; PG8_SCHED;
            PG8_STAGE(PG8_SB(1, 1), b3 + hstep, voffB);
            PG8_WAIT_V(6); PG8_BAR; PG8_MMA(1, 1, At, B1); PG8_BAR;
        }
        const bool keep = E(acc, cur, wr, wc, fr, fq);
        if (!has_next) break;
        if (!keep) {
#pragma unroll
            for (int a = 0; a < 2; ++a)
#pragma unroll
                for (int b = 0; b < 2; ++b)
#pragma unroll
                    for (int m = 0; m < 4; ++m)
#pragma unroll
                        for (int n = 0; n < 2; ++n) acc[a][b][m][n] = (f32x4){0.f, 0.f, 0.f, 0.f};
        }
        cur = nxt; cA = nA; cB = nB; ++ui;
    }
    PG8_WAIT_V(0);
    if (wr == 0) PG8_BAR;
    PG8_BAR;
#undef PG8_SA
#undef PG8_SB
#undef PG8_STAGE
#undef PG8_LDA
#undef PG8_LDB
#undef PG8_MMA
#undef PG8_WAIT_V
#undef PG8_WAIT_L
#undef PG8_BAR
#undef PG8_SCHED
}

struct TileDesc { const float* W; bf16_t* Bt; int K, N, mapmode, tile; };
__device__ __forceinline__ TileDesc tile_desc(const Params& p, unsigned char* ws, int t, int set) {
    TileDesc d;
    if (set == 0) {
        if (t < 1408) { d.W = p.ffn1_w_in; d.Bt = (bf16_t*)(ws + OFF_WFFN_IN); d.K = D; d.N = 2 * DFF; d.mapmode = 1; d.tile = t; }
        else if ((t -= 1408) < 704) { d.W = p.ffn1_w_out; d.Bt = (bf16_t*)(ws + OFF_WFFN_OUT); d.K = DFF; d.N = D; d.mapmode = 0; d.tile = t; }
        else if ((t -= 704) < 1344) { d.W = p.mix_w_in; d.Bt = (bf16_t*)(ws + OFF_WMIX); d.K = D; d.N = INW; d.mapmode = 2; d.tile = t; }
        else if ((t -= 1344) < 128) { d.W = p.w_o_attn; d.Bt = (bf16_t*)(ws + OFF_WOA); d.K = 512; d.N = D; d.mapmode = 0; d.tile = t; }
        else if ((t -= 128) < 128) { d.W = p.w_o_hgrn; d.Bt = (bf16_t*)(ws + OFF_WOH); d.K = 512; d.N = D; d.mapmode = 0; d.tile = t; }
        else { t -= 128; d.W = p.w_out; d.Bt = (bf16_t*)(ws + OFF_WOUT); d.K = D; d.N = D; d.mapmode = 0; d.tile = t; }
    } else {
        if (t < 1408) { d.W = p.ffn2_w_in; d.Bt = (bf16_t*)(ws + OFF_WFFN_IN); d.K = D; d.N = 2 * DFF; d.mapmode = 1; d.tile = t; }
        else { d.W = p.ffn2_w_out; d.Bt = (bf16_t*)(ws + OFF_WFFN_OUT); d.K = DFF; d.N = D; d.mapmode = 0; d.tile = t - 1408; }
    }
    return d;
}
__device__ __forceinline__ void convert_tiles(const Params& p, unsigned char* ws, int set, int ntiles, int first, int stride, LAS float* tl, int tid) {
    if (first >= ntiles) return;
    const int kk = tid >> 4, n4 = (tid & 15) * 4;
#define TILE_LOAD(dsc, A0, A1) do { const int ntn_ = (dsc).N >> 6, tk_ = (dsc).tile / ntn_, tn_ = (dsc).tile - tk_ * ntn_; \
        const float* src_ = (dsc).W + (size_t)(tk_ * 64 + kk) * (dsc).N + tn_ * 64 + n4; A0 = *(const f32x4*)src_; A1 = *(const f32x4*)(src_ + (size_t)32 * (dsc).N); } while (0)
#define CV_BAR() do { asm volatile("s_waitcnt lgkmcnt(0)" ::: "memory"); __builtin_amdgcn_s_barrier(); asm volatile("" ::: "memory"); } while (0)
    TileDesc cur = tile_desc(p, ws, first, set); f32x4 v0, v1; TILE_LOAD(cur, v0, v1);
    for (int t = first; t < ntiles; t += stride) {
        TileDesc nxt = cur; f32x4 n0 = v0, n1 = v1;
        if (t + stride < ntiles) { nxt = tile_desc(p, ws, t + stride, set); TILE_LOAD(nxt, n0, n1); }
#pragma unroll
        for (int j = 0; j < 4; ++j) { tl[kk * 65 + n4 + j] = v0[j]; tl[(kk + 32) * 65 + n4 + j] = v1[j]; }
        CV_BAR();
        {
            const int ntn = cur.N >> 6, tk = cur.tile / ntn, tn = cur.tile - tk * ntn, k0 = tk * 64, n0c = tn * 64;
            const int n = tid >> 3, ks = tid & 7; float v[8];
#pragma unroll
            for (int j = 0; j < 8; ++j) v[j] = tl[(ks * 8 + j) * 65 + n];
            int col = n0c + n, row = col;
            if (cur.mapmode == 1) { const int bj = col >= DFF ? 1 : 0, rem = col - bj * DFF; row = (rem >> 7) * 256 + bj * 128 + (rem & 127); }
            if (cur.mapmode == 2 && col < 640) { const int i32 = col & 31; row = (col & ~31) + 8 * ((i32 >> 2) & 3) + 4 * (i32 >> 4) + (i32 & 3); }
            u32x4 w; w.x = cvt_pk_bf16(v[0], v[1]); w.y = cvt_pk_bf16(v[2], v[3]); w.z = cvt_pk_bf16(v[4], v[5]); w.w = cvt_pk_bf16(v[6], v[7]);
            *(u32x4*)(cur.Bt + (size_t)row * cur.K + k0 + ks * 8) = w;
        }
        CV_BAR();
        cur = nxt; v0 = n0; v1 = n1;
    }
    __syncthreads();
#undef TILE_LOAD
#undef CV_BAR
}

__device__ __forceinline__ void mod_partial_item(const Params& p, int item, LAS float* sl, int tid) {
    const int ks = item / 18, chunk = item - ks * 18, col = chunk * 512 + tid;
    for (int i = tid; i < 17 * 64; i += 512) { const int b = i >> 6, kk = i & 63; const float cv = b < 16 ? p.c[b * D + ks * 64 + kk] : p.c_ctx[ks * 64 + kk]; sl[i] = siluf_(cv); }
    __syncthreads();
    float acc[17];
#pragma unroll
    for (int b = 0; b < 17; ++b) acc[b] = 0.f;
    const float* w = p.w_ada + (size_t)(ks * 64) * (NMOD * D) + col;
    for (int k0 = 0; k0 < 64; k0 += 16) {
        float wv[16];
#pragma unroll
        for (int j = 0; j < 16; ++j) wv[j] = w[(size_t)(k0 + j) * (NMOD * D)];
#pragma unroll
        for (int j = 0; j < 16; ++j)
#pragma unroll
            for (int b = 0; b < 17; ++b) acc[b] += sl[b * 64 + k0 + j] * wv[j];
    }
    float* part = (float*)(p.ws + OFF_PART);
#pragma unroll
    for (int b = 0; b < 17; ++b) part[(size_t)(ks * 17 + b) * (NMOD * D) + col] = acc[b];
    __syncthreads();
}

__device__ __forceinline__ void row_op(const float* src, const bf16_t* y, float w, const float* gate, const float* gpost, float* xdst,
                                       const float* gpre, const float* shift, const float* scale, bf16_t* hdst, int lane) {
    f32x4 v[4];
#pragma unroll
    for (int i = 0; i < 4; ++i) v[i] = *(const f32x4*)(src + i * 256 + lane * 4);
    if (y) {
        f32x4 yv[4]; float ss = 0.f;
#pragma unroll
        for (int i = 0; i < 4; ++i) { const u32x2 raw = *(const u32x2*)(y + i * 256 + lane * 4); yv[i] = (f32x4){bflo(raw.x), bfhi(raw.x), bflo(raw.y), bfhi(raw.y)};
            ss += yv[i][0] * yv[i][0] + yv[i][1] * yv[i][1] + yv[i][2] * yv[i][2] + yv[i][3] * yv[i][3]; }
        ss = wave_sum(ss);
        const float rstd = rsqrtf(ss * (1.0f / D) + EPS);
#pragma unroll
        for (int i = 0; i < 4; ++i) { const f32x4 g = *(const f32x4*)(gate + i * 256 + lane * 4), gp = *(const f32x4*)(gpost + i * 256 + lane * 4);
            v[i] = v[i] + (w * g) * ((yv[i] * rstd) * gp); }
        if (xdst) {
#pragma unroll
            for (int i = 0; i < 4; ++i) *(f32x4*)(xdst + i * 256 + lane * 4) = v[i];
        }
    }
    if (hdst) {
        float ss = 0.f;
#pragma unroll
        for (int i = 0; i < 4; ++i) ss += v[i][0] * v[i][0] + v[i][1] * v[i][1] + v[i][2] * v[i][2] + v[i][3] * v[i][3];
        ss = wave_sum(ss);
        const float rstd = rsqrtf(ss * (1.0f / D) + EPS);
#pragma unroll
        for (int i = 0; i < 4; ++i) { const f32x4 g = *(const f32x4*)(gpre + i * 256 + lane * 4), sh = *(const f32x4*)(shift + i * 256 + lane * 4), sc = *(const f32x4*)(scale + i * 256 + lane * 4);
            const f32x4 h = ((v[i] * rstd) * g) * (1.0f + sc) + sh;
            u32x2 o; o.x = cvt_pk_bf16(h[0], h[1]); o.y = cvt_pk_bf16(h[2], h[3]);
            *(u32x2*)(hdst + i * 256 + lane * 4) = o; }
    }
}

template <bool HASY, bool HASH, bool SRCBF, int XMODE>
__device__ __forceinline__ void rows_phase(const float* mod, int r0, int r1, const float* srcLat, const float* srcCtx, const bf16_t* srcB, const bf16_t* ybuf, float w, int gate_j,
                                           const float* gpost, void* xdst, const float* gpre, int shift_j, bf16_t* hdst, int lane) {
    f32x4 PA[4], PB[4], PC[4];
    f32x4 cv[4], nv[4]; u32x2 cy[4], ny[4];
    int curb = -1;
#define ROW_LOAD(V, Y, r) do { \
        if (SRCBF) { _Pragma("unroll") for (int i = 0; i < 4; ++i) { const u32x2 raw_ = *(const u32x2*)(srcB + (size_t)(r) * D + i * 256 + lane * 4); V[i] = (f32x4){bflo(raw_.x), bfhi(raw_.x), bflo(raw_.y), bfhi(raw_.y)}; } } \
        else { const float* sp_ = (r) < MLAT ? srcLat + (size_t)(r) * D : srcCtx + (size_t)((r) - MLAT) * D; \
            _Pragma("unroll") for (int i = 0; i < 4; ++i) V[i] = *(const f32x4*)(sp_ + i * 256 + lane * 4); } \
        if (HASY) { _Pragma("unroll") for (int i = 0; i < 4; ++i) Y[i] = *(const u32x2*)(ybuf + (size_t)(r) * D + i * 256 + lane * 4); } } while (0)
    ROW_LOAD(cv, cy, r0);
    f32x4 sxf[4]; u32x2 sxb[4], shb[4]; int rs = -1;
#define ROW_STORE() do { if (rs >= 0) { \
        if (HASY && XMODE == 2) { _Pragma("unroll") for (int i = 0; i < 4; ++i) *(f32x4*)((float*)xdst + (size_t)rs * D + i * 256 + lane * 4) = sxf[i]; } \
        if (HASY && XMODE == 1 && rs < MLAT) { _Pragma("unroll") for (int i = 0; i < 4; ++i) *(u32x2*)((bf16_t*)xdst + (size_t)rs * D + i * 256 + lane * 4) = sxb[i]; } \
        if (HASH) { _Pragma("unroll") for (int i = 0; i < 4; ++i) *(u32x2*)(hdst + (size_t)rs * D + i * 256 + lane * 4) = shb[i]; } } } while (0)
    for (int r = r0; r < r1; ++r) {
        ROW_STORE();
        if (r + 1 < r1) ROW_LOAD(nv, ny, r + 1);
        const int bb = r < MLAT ? (r >> 11) : 16;
        if (bb != curb) {
            curb = bb;
            const float* mr = mod + (size_t)bb * NMOD * D;
#pragma unroll
            for (int i = 0; i < 4; ++i) {
                const int cix = i * 256 + lane * 4;
                if (HASY) PA[i] = (*(const f32x4*)(mr + gate_j * D + cix) * w) * *(const f32x4*)(gpost + cix);
                if (HASH) { PB[i] = *(const f32x4*)(gpre + cix) * (1.0f + *(const f32x4*)(mr + (shift_j + 1) * D + cix)); PC[i] = *(const f32x4*)(mr + shift_j * D + cix); }
            }
        }
        if (HASY) {
            f32x4 yv[4]; float ss = 0.f;
#pragma unroll
            for (int i = 0; i < 4; ++i) { yv[i] = (f32x4){bflo(cy[i].x), bfhi(cy[i].x), bflo(cy[i].y), bfhi(cy[i].y)};
                ss += yv[i][0] * yv[i][0] + yv[i][1] * yv[i][1] + yv[i][2] * yv[i][2] + yv[i][3] * yv[i][3]; }
            ss = wave_sum(ss);
            const float rstd = rsqrtf(ss * (1.0f / D) + EPS);
#pragma unroll
            for (int i = 0; i < 4; ++i) cv[i] = cv[i] + PA[i] * (yv[i] * rstd);
            if (XMODE == 2) {
#pragma unroll
                for (int i = 0; i < 4; ++i) sxf[i] = cv[i];
            }
            if (XMODE == 1) {
#pragma unroll
                for (int i = 0; i < 4; ++i) { u32x2 o; o.x = cvt_pk_bf16(cv[i][0], cv[i][1]); o.y = cvt_pk_bf16(cv[i][2], cv[i][3]); sxb[i] = o;
                    if (r < MLAT) cv[i] = (f32x4){bflo(o.x), bfhi(o.x), bflo(o.y), bfhi(o.y)}; }
            }
        }
        if (HASH) {
            float ss = 0.f;
#pragma unroll
            for (int i = 0; i < 4; ++i) ss += cv[i][0] * cv[i][0] + cv[i][1] * cv[i][1] + cv[i][2] * cv[i][2] + cv[i][3] * cv[i][3];
            ss = wave_sum(ss);
            const float rstd = rsqrtf(ss * (1.0f / D) + EPS);
#pragma unroll
            for (int i = 0; i < 4; ++i) { const f32x4 h = (cv[i] * rstd) * PB[i] + PC[i];
                u32x2 o; o.x = cvt_pk_bf16(h[0], h[1]); o.y = cvt_pk_bf16(h[2], h[3]); shb[i] = o; }
        }
        rs = r;
#pragma unroll
        for (int i = 0; i < 4; ++i) { cv[i] = nv[i]; cy[i] = ny[i]; }
    }
    ROW_STORE();
#undef ROW_STORE
#undef ROW_LOAD
}

__device__ __forceinline__ void attn_item(const Params& p, int item, int wid, int lane) {
    const bf16_t* qbuf = (const bf16_t*)(p.ws + OFF_QBUF);
    const bf16_t* kall = (const bf16_t*)(p.ws + OFF_KALL);
    const bf16_t* vtall = (const bf16_t*)(p.ws + OFF_VT);
    bf16_t* oatt = (bf16_t*)(p.ws + OFF_OATT);
    const int qb = item & 15, kvh = (item >> 4) & 1, b = item >> 5;
    const int g = wid >> 1, qh = wid & 1, head = kvh * 4 + g, q0 = qb * 128 + qh * 64;
    const int fr = lane & 15, fq = lane >> 4;
    const bf16_t* Kp = kall + (size_t)(b * 2 + kvh) * 2304 * 64;
    const bf16_t* Vp = vtall + (size_t)(b * 2 + kvh) * 64 * 2304;
    bf16x8 qf[4][2];
#pragma unroll
    for (int qt = 0; qt < 4; ++qt)
#pragma unroll
        for (int kk = 0; kk < 2; ++kk) qf[qt][kk] = *(const bf16x8*)(qbuf + (size_t)(b * T + q0 + qt * 16 + fr) * 512 + head * 64 + kk * 32 + fq * 8);
    f32x4 o[4][4]; float mrun[4], lrun[4];
#pragma unroll
    for (int qt = 0; qt < 4; ++qt) { mrun[qt] = -1e30f; lrun[qt] = 0.f;
#pragma unroll
        for (int dt = 0; dt < 4; ++dt) o[qt][dt] = (f32x4){0.f, 0.f, 0.f, 0.f}; }
    const int kb_lo = q0 - 128 < 0 ? 0 : q0 - 128, kb_hi = q0 + 192 > T ? T : q0 + 192;
    const int nband = (kb_hi - kb_lo) >> 5;
    for (int it = 0; it < nband + 8; ++it) {
        const bool band = it < nband;
        const int key0 = band ? kb_lo + it * 32 : T + (it - nband) * 32;
        bf16x8 kf[2][2];
#pragma unroll
        for (int kt = 0; kt < 2; ++kt)
#pragma unroll
            for (int kk = 0; kk < 2; ++kk) kf[kt][kk] = *(const bf16x8*)(Kp + (size_t)(key0 + kt * 16 + fr) * 64 + kk * 32 + fq * 8);
        bf16x8 vf[4];
#pragma unroll
        for (int dt = 0; dt < 4; ++dt) {
            const bf16_t* vp = Vp + (size_t)(dt * 16 + fr) * 2304 + key0 + fq * 4;
            const u32x2 lo = *(const u32x2*)vp, hi = *(const u32x2*)(vp + 16);
            u32x4 w; w.x = lo.x; w.y = lo.y; w.z = hi.x; w.w = hi.y;
            vf[dt] = __builtin_bit_cast(bf16x8, w);
        }
        f32x4 sc[4][2];
#pragma unroll
        for (int qt = 0; qt < 4; ++qt) {
            f32x4 s0 = (f32x4){0.f, 0.f, 0.f, 0.f}, s1 = (f32x4){0.f, 0.f, 0.f, 0.f};
            s0 = __builtin_amdgcn_mfma_f32_16x16x32_bf16(kf[0][0], qf[qt][0], s0, 0, 0, 0);
            s0 = __builtin_amdgcn_mfma_f32_16x16x32_bf16(kf[0][1], qf[qt][1], s0, 0, 0, 0);
            s1 = __builtin_amdgcn_mfma_f32_16x16x32_bf16(kf[1][0], qf[qt][0], s1, 0, 0, 0);
            s1 = __builtin_amdgcn_mfma_f32_16x16x32_bf16(kf[1][1], qf[qt][1], s1, 0, 0, 0);
            sc[qt][0] = s0; sc[qt][1] = s1;
        }
        float mx[4];
#pragma unroll
        for (int qt = 0; qt < 4; ++qt)
            mx[qt] = fmaxf(fmaxf(fmaxf(sc[qt][0][0], sc[qt][0][1]), fmaxf(sc[qt][0][2], sc[qt][0][3])), fmaxf(fmaxf(sc[qt][1][0], sc[qt][1][1]), fmaxf(sc[qt][1][2], sc[qt][1][3])));
        const bool needmask = band && (key0 - q0 < -65 || key0 - q0 > 97);
        if (needmask) {
            const int dbase = key0 + fq * 4 - (q0 + fr);
#pragma unroll
            for (int qt = 0; qt < 4; ++qt) {
#pragma unroll
                for (int r = 0; r < 4; ++r) {
                    const int d0 = dbase + r - qt * 16, d1 = d0 + 16;
                    sc[qt][0][r] = (d0 > 128 || d0 < -128) ? -1e30f : sc[qt][0][r];
                    sc[qt][1][r] = (d1 > 128 || d1 < -128) ? -1e30f : sc[qt][1][r];
                }
                mx[qt] = fmaxf(fmaxf(fmaxf(sc[qt][0][0], sc[qt][0][1]), fmaxf(sc[qt][0][2], sc[qt][0][3])), fmaxf(fmaxf(sc[qt][1][0], sc[qt][1][1]), fmaxf(sc[qt][1][2], sc[qt][1][3])));
            }
        }
        float t16[4];
#pragma unroll
        for (int qt = 0; qt < 4; ++qt) t16[qt] = __shfl_xor(mx[qt], 16);
#pragma unroll
        for (int qt = 0; qt < 4; ++qt) mx[qt] = fmaxf(mx[qt], t16[qt]);
#pragma unroll
        for (int qt = 0; qt < 4; ++qt) t16[qt] = __shfl_xor(mx[qt], 32);
        float alpha[4]; bool resc = false;
#pragma unroll
        for (int qt = 0; qt < 4; ++qt) {
            mx[qt] = fmaxf(mx[qt], t16[qt]);
            const float mn = fmaxf(mrun[qt], mx[qt]);
            alpha[qt] = __builtin_amdgcn_exp2f(mrun[qt] - mn);
            resc = resc || (mn != mrun[qt]);
            mrun[qt] = mn;
        }
        bf16x8 pb[4];
#pragma unroll
        for (int qt = 0; qt < 4; ++qt) {
            float pr[8];
#pragma unroll
            for (int r = 0; r < 4; ++r) { pr[r] = __builtin_amdgcn_exp2f(sc[qt][0][r] - mrun[qt]); pr[4 + r] = __builtin_amdgcn_exp2f(sc[qt][1][r] - mrun[qt]); }
            lrun[qt] = lrun[qt] * alpha[qt] + ((pr[0] + pr[1]) + (pr[2] + pr[3])) + ((pr[4] + pr[5]) + (pr[6] + pr[7]));
            u32x4 pw; pw.x = cvt_pk_bf16(pr[0], pr[1]); pw.y = cvt_pk_bf16(pr[2], pr[3]); pw.z = cvt_pk_bf16(pr[4], pr[5]); pw.w = cvt_pk_bf16(pr[6], pr[7]);
            pb[qt] = __builtin_bit_cast(bf16x8, pw);
        }
        if (__any(resc)) {
#pragma unroll
            for (int qt = 0; qt < 4; ++qt)
#pragma unroll
                for (int dt = 0; dt < 4; ++dt) o[qt][dt] *= alpha[qt];
        }
#pragma unroll
        for (int qt = 0; qt < 4; ++qt)
#pragma unroll
            for (int dt = 0; dt < 4; ++dt) o[qt][dt] = __builtin_amdgcn_mfma_f32_16x16x32_bf16(vf[dt], pb[qt], o[qt][dt], 0, 0, 0);
    }
    const float sink = p.attn_sink[head];
#pragma unroll
    for (int qt = 0; qt < 4; ++qt) {
        float lt = lrun[qt]; lt += __shfl_xor(lt, 16); lt += __shfl_xor(lt, 32);
        lt += __builtin_amdgcn_exp2f(sink * 1.44269504f - mrun[qt]);
        const float inv = 1.0f / lt;
        bf16_t* dst = oatt + (size_t)(b * T + q0 + qt * 16 + fr) * 512 + head * 64 + fq * 4;
#pragma unroll
        for (int dt = 0; dt < 4; ++dt) { const f32x4 v = o[qt][dt] * inv; u32x2 w; w.x = cvt_pk_bf16(v[0], v[1]); w.y = cvt_pk_bf16(v[2], v[3]); *(u32x2*)(dst + dt * 16) = w; }
    }
}

constexpr int LQS = 0, LQT = 17408, LKT = 34816, LST = 52224, LKDT = 87040, LVT = 105472, LPP = 123904, LCUM = 133120, LDEC = 135168, LROPE = 131072, LXST = 139264;
__device__ __forceinline__ void hgrn_unit(const Params& p, int unit, LAS unsigned char* lds, int tid) {
    const int dir = unit & 1, h = (unit >> 1) & 3, b = unit >> 3;
    const int wid = tid >> 6, lane = tid & 63, fr = lane & 15, fq = lane >> 4;
    const bf16_t* hbuf = (const bf16_t*)(p.ws + OFF_HBUF);
    bf16_t* odir = (bf16_t*)(p.ws + OFF_ODIR) + (size_t)dir * MLAT * 512;
    LAS bf16_t* Lqs = (LAS bf16_t*)(lds + LQS); LAS bf16_t* Lqt = (LAS bf16_t*)(lds + LQT); LAS bf16_t* Lkt = (LAS bf16_t*)(lds + LKT);
    LAS bf16_t* Lst = (LAS bf16_t*)(lds + LST); LAS bf16_t* Lkdt = (LAS bf16_t*)(lds + LKDT); LAS bf16_t* Lvt = (LAS bf16_t*)(lds + LVT);
    LAS bf16_t* Lp = (LAS bf16_t*)(lds + LPP); LAS float* Lcum = (LAS float*)(lds + LCUM); LAS float* Ldec = (LAS float*)(lds + LDEC);
    const int d = tid & 127, tg = tid >> 7;
    const float* lbraw = dir ? p.lb_bwd : p.lb_fwd;
    const float lbv = 1.0f / (1.0f + __expf(lbraw[512 + h * 128 + d] - lbraw[h * 128 + d]));
    const int colF = (dir ? 1024 : 512) + h * 128 + d, colQ = h * 128 + d, colV = 1536 + h * 128 + d;
    f32x4 Sacc[8];
#pragma unroll
    for (int ei = 0; ei < 8; ++ei) Sacc[ei] = (f32x4){0.f, 0.f, 0.f, 0.f};
#define LDSBAR() do { asm volatile("s_waitcnt lgkmcnt(0)" ::: "memory"); __builtin_amdgcn_s_barrier(); asm volatile("" ::: "memory"); } while (0)
    bf16_t pz[16], pq[16], pv[16];
#define HG_LOAD(cn) do { const bool latn_ = (cn) >= 4; const int ccn_ = latn_ ? (cn) - 4 : (cn); const int rbn_ = latn_ ? b * T : MLAT + b * L; const int sln_ = latn_ ? T - 1 : L - 1; \
        _Pragma("unroll") for (int i = 0; i < 16; ++i) { const int tl_ = ccn_ * 64 + tg * 16 + i, tok_ = dir ? sln_ - tl_ : tl_; const bf16_t* rp_ = hbuf + (size_t)(rbn_ + tok_) * 2048; pz[i] = rp_[colF]; pv[i] = rp_[colV]; if (latn_) pq[i] = rp_[colQ]; } } while (0)
#pragma unroll
    for (int i = 0; i < 16; ++i) pq[i] = 0;
    HG_LOAD(0);
#pragma unroll
    for (int ei = 0; ei < 8; ++ei) { u32x2 z; z.x = 0u; z.y = 0u; *(LAS u32x2*)(Lst + (ei * 16 + fr) * 136 + wid * 16 + fq * 4) = z; }
    LDSBAR();
    for (int c = 0; c < 36; ++c) {
        const bool lat = c >= 4;
        const int cc = lat ? c - 4 : c;
        const int rowbase = lat ? b * T : MLAT + b * L;
        const int seglast = lat ? T - 1 : L - 1;
        float gp[16], kk[16];
#pragma unroll
        for (int i = 0; i < 16; ++i) {
            const float z = bf2f(pz[i]);
            const float f = lbv + (1.0f - lbv) * sigmoidf_(z);
            gp[i] = f; kk[i] = 1.0f - f;
        }
        { float run = gp[15];
#pragma unroll
          for (int i = 14; i >= 0; --i) { kk[i] *= run; run *= gp[i]; } }
#pragma unroll
        for (int i = 1; i < 16; ++i) gp[i] *= gp[i - 1];
        Lcum[tg * 128 + d] = __logf(gp[15]);
        LDSBAR();
        const float c0 = Lcum[d], c1 = Lcum[128 + d], c2 = Lcum[256 + d], c3 = Lcum[384 + d];
        const float off = tg == 0 ? 0.f : tg == 1 ? c0 : tg == 2 ? c0 + c1 : c0 + c1 + c2;
        const float mid = c0 + c1, tot = (c0 + c1) + (c2 + c3);
        const float e_off = __expf(off), e_om = __expf(off - mid), e_mo = __expf(mid - off), e_to = __expf(tot - off);
        const float rgl = __builtin_amdgcn_rcpf(gp[15]);
#define rg kk
#pragma unroll
        for (int i = 0; i < 16; ++i) kk[i] *= rgl;
        if (lat) {
#pragma unroll
            for (int i = 0; i < 16; ++i) {
                const int t = tg * 16 + i;
                const float qg = bf2f(pq[i]) * gp[i];
                Lqs[t * 136 + d] = f2bf(qg * e_off);
                Lqt[t * 136 + d] = f2bf(qg * e_om);
                Lkt[t * 136 + d] = f2bf(rg[i] * e_mo);
            }
        }
        {
            u32x4 w0, w1;
            w0.x = cvt_pk_bf16(rg[0] * e_to, rg[1] * e_to); w0.y = cvt_pk_bf16(rg[2] * e_to, rg[3] * e_to); w0.z = cvt_pk_bf16(rg[4] * e_to, rg[5] * e_to); w0.w = cvt_pk_bf16(rg[6] * e_to, rg[7] * e_to);
            w1.x = cvt_pk_bf16(rg[8] * e_to, rg[9] * e_to); w1.y = cvt_pk_bf16(rg[10] * e_to, rg[11] * e_to); w1.z = cvt_pk_bf16(rg[12] * e_to, rg[13] * e_to); w1.w = cvt_pk_bf16(rg[14] * e_to, rg[15] * e_to);
            *(LAS u32x4*)(Lkdt + d * 72 + tg * 16) = w0; *(LAS u32x4*)(Lkdt + d * 72 + tg * 16 + 8) = w1;
            if (tg == 0) Ldec[d] = __expf(tot);
        }
        {
            u32x4 w0, w1;
            w0.x = pv[0] | ((unsigned)pv[1] << 16); w0.y = pv[2] | ((unsigned)pv[3] << 16); w0.z = pv[4] | ((unsigned)pv[5] << 16); w0.w = pv[6] | ((unsigned)pv[7] << 16);
            w1.x = pv[8] | ((unsigned)pv[9] << 16); w1.y = pv[10] | ((unsigned)pv[11] << 16); w1.z = pv[12] | ((unsigned)pv[13] << 16); w1.w = pv[14] | ((unsigned)pv[15] << 16);
            *(LAS u32x4*)(Lvt + d * 72 + tg * 16) = w0; *(LAS u32x4*)(Lvt + d * 72 + tg * 16 + 8) = w1;
        }
        if (c + 1 < 36) HG_LOAD(c + 1);
        LDSBAR();
        if (lat) {
            const int ti = wid >> 1;
#pragma unroll
            for (int uu = 0; uu < 2; ++uu) {
                const int si = (wid & 1) * 2 + uu;
                f32x4 a = (f32x4){0.f, 0.f, 0.f, 0.f};
#pragma unroll
                for (int k4 = 0; k4 < 4; ++k4) {
                    const bf16x8 af = *(const LAS bf16x8*)(Lqt + (ti * 16 + fr) * 136 + k4 * 32 + fq * 8);
                    const bf16x8 bf = *(const LAS bf16x8*)(Lkt + (si * 16 + fr) * 136 + k4 * 32 + fq * 8);
                    a = __builtin_amdgcn_mfma_f32_16x16x32_bf16(af, bf, a, 0, 0, 0);
                }
                const int s = si * 16 + fr;
#pragma unroll
                for (int r = 0; r < 4; ++r) { const int t = ti * 16 + fq * 4 + r; const float v = (si <= ti && s <= t) ? a[r] : 0.f; Lp[t * 72 + s] = f2bf(v); }
            }
            LDSBAR();
#pragma unroll
            for (int uu = 0; uu < 4; ++uu) {
                const int ei = (wid & 1) * 4 + uu;
                f32x4 a = (f32x4){0.f, 0.f, 0.f, 0.f};
#pragma unroll
                for (int k4 = 0; k4 < 4; ++k4) {
                    const bf16x8 af = *(const LAS bf16x8*)(Lqs + (ti * 16 + fr) * 136 + k4 * 32 + fq * 8);
                    const bf16x8 bf = *(const LAS bf16x8*)(Lst + (ei * 16 + fr) * 136 + k4 * 32 + fq * 8);
                    a = __builtin_amdgcn_mfma_f32_16x16x32_bf16(af, bf, a, 0, 0, 0);
                }
#pragma unroll
                for (int k2 = 0; k2 < 2; ++k2) {
                    const bf16x8 af = *(const LAS bf16x8*)(Lp + (ti * 16 + fr) * 72 + k2 * 32 + fq * 8);
                    const bf16x8 bf = *(const LAS bf16x8*)(Lvt + (ei * 16 + fr) * 72 + k2 * 32 + fq * 8);
                    a = __builtin_amdgcn_mfma_f32_16x16x32_bf16(af, bf, a, 0, 0, 0);
                }
#pragma unroll
                for (int r = 0; r < 4; ++r) {
                    const int tl = cc * 64 + ti * 16 + fq * 4 + r, tok = dir ? seglast - tl : tl;
                    odir[(size_t)(rowbase + tok) * 512 + h * 128 + ei * 16 + fr] = f2bf(a[r]);
                }
            }
        }
        {
            const f32x4 dec = *(const LAS f32x4*)(Ldec + wid * 16 + fq * 4);
#pragma unroll
            for (int ei = 0; ei < 8; ++ei) {
                f32x4 a = Sacc[ei] * dec;
#pragma unroll
                for (int k2 = 0; k2 < 2; ++k2) {
                    const bf16x8 af = *(const LAS bf16x8*)(Lkdt + (wid * 16 + fr) * 72 + k2 * 32 + fq * 8);
                    const bf16x8 bf = *(const LAS bf16x8*)(Lvt + (ei * 16 + fr) * 72 + k2 * 32 + fq * 8);
                    a = __builtin_amdgcn_mfma_f32_16x16x32_bf16(af, bf, a, 0, 0, 0);
                }
                Sacc[ei] = a;
            }
        }
        LDSBAR();
#pragma unroll
        for (int ei = 0; ei < 8; ++ei) { u32x2 w; w.x = cvt_pk_bf16(Sacc[ei][0], Sacc[ei][1]); w.y = cvt_pk_bf16(Sacc[ei][2], Sacc[ei][3]);
            *(LAS u32x2*)(Lst + (ei * 16 + fr) * 136 + wid * 16 + fq * 4) = w; }
    }
    __syncthreads();
#undef HG_LOAD
#undef rg
}

#define XB_TMO      128
#define XB_XCNT(j)  (256  + 64 * (j))
#define XB_XSUB(j)  (1280 + 64 * (j))
#define XB_XGEN(j)  (2304 + 64 * (j))
#define XB_TOP      3328
#define XB_TOPGEN   3392
#define XCD_BAR_WORDS 3456
#define XB_SPIN_CAP (1u << 20)
__device__ __forceinline__ unsigned xb_ld(unsigned* p)              { return __hip_atomic_load(p, __ATOMIC_RELAXED, __HIP_MEMORY_SCOPE_AGENT); }
__device__ __forceinline__ unsigned xb_add(unsigned* p, unsigned v) { return __hip_atomic_fetch_add(p, v, __ATOMIC_RELAXED, __HIP_MEMORY_SCOPE_AGENT); }
__device__ __forceinline__ unsigned xb_xcc_id() { return (unsigned)__builtin_amdgcn_s_getreg((3 << 11) | 20) & 0xFu; }
#define XB_SPIN(cond, bar) do { unsigned _sp = 0; while (cond) { __builtin_amdgcn_s_sleep(1); \
    if ((++_sp & 255u) == 0u) { if (xb_ld(&(bar)[XB_TMO])) break; if (_sp > XB_SPIN_CAP) { atomicAdd(&(bar)[XB_TMO], 1u); break; } } } } while (0)
__device__ __forceinline__ void xcd_barrier_complete(unsigned* bar, unsigned x, unsigned& nloc, unsigned& nx) {
    const unsigned G = gridDim.x * gridDim.y * gridDim.z;
    unsigned sum, cnt, mine, sp = 0u;
    for (;;) {
        sum = 0u; cnt = 0u; mine = 0u;
#pragma unroll
        for (unsigned j = 0; j < 16; ++j) { const unsigned c = xb_ld(&bar[XB_XCNT(j)]); sum += c; cnt += (c > 0u) ? 1u : 0u; mine = (j == x) ? c : mine; }
        if (sum == G) break;
        __builtin_amdgcn_s_sleep(1);
        if ((++sp & 255u) == 0u) { if (xb_ld(&bar[XB_TMO])) break; if (sp > XB_SPIN_CAP) { atomicAdd(&bar[XB_TMO], 1u); break; } }
    }
    nloc = mine > 0u ? mine : 1u; nx = cnt > 0u ? cnt : 1u;
}
__device__ __forceinline__ void xcd_barrier(unsigned* bar, volatile LAS unsigned* st) {
    asm volatile("s_waitcnt vmcnt(0)" ::: "memory");
    __syncthreads();
    if (threadIdx.x == 0) {
        const unsigned x = xb_xcc_id();
        __builtin_amdgcn_s_waitcnt(0);
        unsigned nloc = st[0], nx = st[1];
        if (nloc == 0u) { xcd_barrier_complete(bar, x, nloc, nx); st[0] = nloc; st[1] = nx; }
        const unsigned old = xb_add(&bar[XB_XSUB(x)], 1u);
        const unsigned gen = old / nloc;
        if (old + 1u == (gen + 1u) * nloc) {
            __builtin_amdgcn_fence(__ATOMIC_RELEASE, "agent");
            asm volatile("s_waitcnt vmcnt(0)" ::: "memory");
            const unsigned og = xb_add(&bar[XB_TOP], 1u);
            const unsigned tg = og / nx;
            if (og + 1u == (tg + 1u) * nx) xb_add(&bar[XB_TOPGEN], 1u);
            else XB_SPIN(xb_ld(&bar[XB_TOPGEN]) == tg, bar);
            __builtin_amdgcn_fence(__ATOMIC_ACQUIRE, "agent");
            xb_add(&bar[XB_XGEN(x)], 1u);
            asm volatile("s_waitcnt vmcnt(0)" ::: "memory");
        } else {
            XB_SPIN(xb_ld(&bar[XB_XGEN(x)]) == gen, bar);
            __builtin_amdgcn_fence(__ATOMIC_ACQUIRE, "agent");
            asm volatile("s_waitcnt vmcnt(0)" ::: "memory");
        }
    }
    __syncthreads();
}

__global__ void __launch_bounds__(512, 2) mega(Params p, int ph_lo, int ph_hi) {
    extern __shared__ __attribute__((aligned(16))) unsigned char shm[];
    LAS unsigned char* lds = (LAS unsigned char*)shm;
    volatile LAS unsigned* xst = (volatile LAS unsigned*)(lds + LXST);
    unsigned* xbar = (unsigned*)(p.ws + OFF_BAR);
    if (threadIdx.x == 0) { xst[0] = 0u; xst[1] = 0u; }
    __syncthreads();
    if (ph_hi - ph_lo > 1 && threadIdx.x == 0) (void)xb_add(&xbar[XB_XCNT(xb_xcc_id())], 1u);
#ifndef PROBE_PH
#define PROBE_PH -1
#define PROBE_EXTRA 0
#endif
    for (int phi = ph_lo; phi < ph_hi + PROBE_EXTRA; ++phi) {
        const int ph = (PROBE_PH < 0 || phi <= PROBE_PH) ? phi : (phi <= PROBE_PH + PROBE_EXTRA ? PROBE_PH : phi - PROBE_EXTRA);
        int tid = threadIdx.x; asm volatile("" : "+v"(tid));
        int G = gridDim.x, c = blockIdx.x; asm volatile("" : "+s"(G), "+s"(c));
        unsigned char* ws = p.ws;
        const int wid = tid >> 6, lane = tid & 63;
        const float* mod = (const float*)(ws + OFF_MOD);
        switch (ph) {
        case 0: if (PH_ON(0)) {
            for (int it = c; it < 288 + 1; it += G) {
                if (it < 288) mod_partial_item(p, it, (LAS float*)lds, tid);
                else { for (int i = tid; i < 1024; i += 512) { const int pos = i >> 4, fi = i & 15; const float fr_ = powf(10000.0f, -(float)fi / 16.0f), ang = (float)pos * fr_;
                        ((float2*)(ws + OFF_ROPE))[i] = make_float2(cosf(ang), sinf(ang)); } }
            }
            __syncthreads();
            convert_tiles(p, ws, 0, 3968, c, G, (LAS float*)lds, tid);
        } break;
        case 1: if (PH_ON(1)) {
            const float* part = (const float*)(ws + OFF_PART);
            for (int i = c * 512 + tid; i < 17 * NMOD * D; i += G * 512) {
                const int n = i % (NMOD * D);
                float s = p.b_ada[n];
#pragma unroll
                for (int ks = 0; ks < 16; ++ks) s += part[(size_t)ks * 17 * NMOD * D + i];
                ((float*)(ws + OFF_MOD))[i] = s;
            }
        } break;
        case 2: if (PH_ON(2)) {
            const int gw = c * 8 + wid, rpw = MALL / (G * 8);
            rows_phase<false, true, false, 0>(mod, gw * rpw, gw * rpw + rpw, p.x, p.ctx, (const bf16_t*)p.out, (const bf16_t*)(ws + OFF_Y), 0.f, 0, p.norm_post, p.out, p.norm_pre, 0, (bf16_t*)(ws + OFF_HA), lane);
        } break;
        case 3: case 13: if (PH_ON(3)) {
            const bool second = ph == 13;
            RectOrder S; S.A = (const char*)(ws + OFF_HA); S.B = (const char*)(ws + OFF_WFFN_IN); S.K = D; S.nM = second ? 128 : 144; S.nN = 22; S.nwg = S.nM * S.nN; S.G = G; S.c = c; S.pm0 = 0;
            EpiSwiglu E; E.act = (bf16_t*)(ws + OFF_ACT);
            gemm_phase(lds, D, S, E, tid);
        } break;
        case 4: case 5: case 11: case 14: if (PH_ON(4)) {
            RectOrder S; S.G = G; S.c = c; S.nN = 4; S.pm0 = 0; int K; bool dogemm = true;
            if (ph == 11) { S.A = (const char*)(ws + OFF_U); S.B = (const char*)(ws + OFF_WOUT); K = D; S.nM = 128; }
            else { S.A = (const char*)(ws + OFF_ACT); S.B = (const char*)(ws + OFF_WFFN_OUT); K = DFF; S.nM = 128; }
            if (ph == 5) {
                if (c >= 64) {
                    dogemm = false;
                    const int nw = (G - 64) * 8, gw = (c - 64) * 8 + wid, rpw = (MLAT + nw - 1) / nw;
                    const int r0 = gw * rpw, r1 = r0 + rpw < MLAT ? r0 + rpw : MLAT;
                    if (r0 < MLAT) rows_phase<true, true, false, 1>(mod, r0, r1, p.x, p.ctx, (const bf16_t*)p.out, (const bf16_t*)(ws + OFF_Y), 0.5f, 2, p.norm_post, p.out, p.norm_pre + D, 3, (bf16_t*)(ws + OFF_HA), lane);
                } else { S.nM = 16; S.pm0 = 128; S.G = 64; }
            }
            S.K = K; S.nwg = S.nM * S.nN;
            if (dogemm) {
                EpiBf16 E; E.C = (bf16_t*)(ws + OFF_Y); E.ldc = D;
                gemm_phase(lds, K, S, E, tid);
            }
        } break;
        case 6: if (PH_ON(5)) {
            const int gw = c * 8 + wid, rpw = MCTX / (G * 8);
            rows_phase<true, true, false, 0>(mod, MLAT + gw * rpw, MLAT + gw * rpw + rpw, p.x, p.ctx, (const bf16_t*)p.out, (const bf16_t*)(ws + OFF_Y), 0.5f, 2, p.norm_post, p.out, p.norm_pre + D, 3, (bf16_t*)(ws + OFF_HA), lane);
        } break;
        case 7: if (PH_ON(6)) {
            MixOrder S; S.A = (const char*)(ws + OFF_HA); S.B = (const char*)(ws + OFF_WMIX); S.G = G; S.c = c;
            EpiMixIn E; E.qbuf = (bf16_t*)(ws + OFF_QBUF); E.kall = (bf16_t*)(ws + OFF_KALL); E.vt = (bf16_t*)(ws + OFF_VT); E.hbuf = (bf16_t*)(ws + OFF_HBUF); E.gbuf = (bf16_t*)(ws + OFF_GBUF);
            ((LAS f32x4*)(lds + 131072))[tid] = ((const f32x4*)(ws + OFF_ROPE))[tid];
            __syncthreads();
            E.rope = (const LAS float2*)(lds + 131072);
            gemm_phase(lds, D, S, E, tid);
        } break;
        case 8: if (PH_ON(7)) {
            const int half = G >> 1;
#ifndef REP_HGRN
#define REP_HGRN 1
#define REP_ATTN 1
#endif
            if (c < half) { for (int rep = 0; rep < REP_HGRN; ++rep) for (int it = c; it < 128; it += half) hgrn_unit(p, it, lds, tid);
                convert_tiles(p, ws, 1, 2112, c, half, (LAS float*)lds, tid); }
            else { int tid2 = tid; asm volatile("" : "+v"(tid2));
                for (int rep = 0; rep < REP_ATTN; ++rep) for (int it = c - half; it < 512; it += G - half) attn_item(p, it, tid2 >> 6, tid2 & 63);
            }
        } break;
        case 9: if (PH_ON(8)) {
            const bf16_t* of = (const bf16_t*)(ws + OFF_ODIR); const bf16_t* ob = of + (size_t)MLAT * 512;
            const bf16_t* gb = (const bf16_t*)(ws + OFF_GBUF); bf16_t* orr = (bf16_t*)(ws + OFF_OR);
            for (int r = c * 8 + wid; r < MLAT; r += G * 8) {
                const u32x4 a = *(const u32x4*)(of + (size_t)r * 512 + lane * 8), bq = *(const u32x4*)(ob + (size_t)r * 512 + lane * 8);
                const u32x4 gq = *(const u32x4*)(gb + (size_t)r * 2560 + lane * 8);
                float v[8]; float ss = 0.f;
#pragma unroll
                for (int q = 0; q < 4; ++q) { v[q * 2] = bflo(a[q]) + bflo(bq[q]); v[q * 2 + 1] = bfhi(a[q]) + bfhi(bq[q]); ss += v[q * 2] * v[q * 2] + v[q * 2 + 1] * v[q * 2 + 1]; }
                ss = wave_sum(ss);
                const float rstd = rsqrtf(ss * (1.0f / 512.0f) + EPS);
                const f32x4 g0 = *(const f32x4*)(p.hgrn_norm + lane * 8), g1 = *(const f32x4*)(p.hgrn_norm + lane * 8 + 4);
                float o[8];
#pragma unroll
                for (int q = 0; q < 4; ++q) {
                    const float h0 = bflo(gq[q]), h1 = bfhi(gq[q]);
                    const float gg0 = q < 2 ? g0[q * 2] : g1[q * 2 - 4], gg1 = q < 2 ? g0[q * 2 + 1] : g1[q * 2 - 3];
                    o[q * 2] = v[q * 2] * rstd * gg0 * siluf_(h0); o[q * 2 + 1] = v[q * 2 + 1] * rstd * gg1 * siluf_(h1);
                }
                u32x4 w; w.x = cvt_pk_bf16(o[0], o[1]); w.y = cvt_pk_bf16(o[2], o[3]); w.z = cvt_pk_bf16(o[4], o[5]); w.w = cvt_pk_bf16(o[6], o[7]);
                *(u32x4*)(orr + (size_t)r * 512 + lane * 8) = w;
            }
            __syncthreads();
        } break;
        case 10: if (PH_ON(9)) {
            MergeOrder S; S.A0 = (const char*)(ws + OFF_OATT); S.B0 = (const char*)(ws + OFF_WOA); S.A1 = (const char*)(ws + OFF_OR); S.B1 = (const char*)(ws + OFF_WOH); S.G = G; S.c = c;
            EpiMerge E; E.gbuf = (const bf16_t*)(ws + OFF_GBUF); E.U = (bf16_t*)(ws + OFF_U);
            gemm_phase(lds, 512, S, E, tid);
        } break;
        case 12: if (PH_ON(11)) {
            const int gw = c * 8 + wid, rpw = MLAT / (G * 8);
            rows_phase<true, true, true, 1>(mod, gw * rpw, gw * rpw + rpw, p.x, p.ctx, (const bf16_t*)p.out, (const bf16_t*)(ws + OFF_Y), 1.0f, 5, p.norm_post + D, ws + OFF_X2, p.norm_pre + 2 * D, 6, (bf16_t*)(ws + OFF_HA), lane);
        } break;
        case 15: if (PH_ON(14)) {
            const int gw = c * 8 + wid, rpw = MLAT / (G * 8);
            rows_phase<true, false, true, 2>(mod, gw * rpw, gw * rpw + rpw, p.x, p.ctx, (const bf16_t*)(ws + OFF_X2), (const bf16_t*)(ws + OFF_Y), 0.5f, 8, p.norm_post + 2 * D, p.out, p.norm_pre, 0, (bf16_t*)(ws + OFF_HA), lane);
        } break;
        default: break;
        }
        if (phi + 1 < ph_hi + PROBE_EXTRA) xcd_barrier(xbar, xst);
    }
}

extern "C" void kernel_launch(void* const* d_in, const int* in_sizes, int n_in, void* d_out, int out_size, void* d_ws, size_t ws_size, hipStream_t stream) {
    static int grid_blocks = 0;
    if (!grid_blocks) {
        hipFuncSetAttribute((const void*)mega, hipFuncAttributeMaxDynamicSharedMemorySize, LDS_BYTES);
        int dev = 0, cus = 0, per_cu = 0;
        hipGetDevice(&dev);
        hipDeviceGetAttribute(&cus, hipDeviceAttributeMultiprocessorCount, dev);
        hipOccupancyMaxActiveBlocksPerMultiprocessor(&per_cu, mega, 512, LDS_BYTES);
        if (per_cu < 1) per_cu = 1;
        if (per_cu > 1) per_cu = 1;
        grid_blocks = cus * per_cu;
        if (grid_blocks > 256) grid_blocks = 256;
    }
    Params p{};
    const float** pp = (const float**)&p;
    for (int i = 0; i < 20; ++i) pp[i] = (const float*)d_in[i];
    p.out = (float*)d_out; p.ws = (unsigned char*)d_ws;
    hipMemsetAsync((unsigned char*)d_ws + OFF_BAR, 0, XCD_BAR_WORDS * sizeof(unsigned), stream);
#if MULTI_LAUNCH
    for (int ph = 0; ph < NPH; ++ph) { hipLaunchKernelGGL(mega, dim3(grid_blocks), dim3(512), LDS_BYTES, stream, p, ph, ph + 1); }
#else
    hipLaunchKernelGGL(mega, dim3(grid_blocks), dim3(512), LDS_BYTES, stream, p, 0, NPH);
#endif
}
```

```cpp
#include <hip/hip_runtime.h>
#include <hip/hip_cooperative_groups.h>
#include <cstdio>
namespace cg = cooperative_groups;

#ifndef MULTI_LAUNCH
#define MULTI_LAUNCH 0
#endif

#ifndef PHASE_MASK
#define PHASE_MASK 0xffff
#endif
#define PH_ON(n) (((PHASE_MASK) >> (n)) & 1)
#define LAS __attribute__((address_space(3)))
typedef unsigned short bf16_t;
typedef short bf16x8 __attribute__((ext_vector_type(8)));
typedef float f32x4 __attribute__((ext_vector_type(4)));
typedef unsigned u32x4 __attribute__((ext_vector_type(4)));
typedef unsigned u32x2 __attribute__((ext_vector_type(2)));

constexpr int D = 1024, NB = 16, T = 2048, L = 256, MLAT = NB * T, MCTX = NB * L, MALL = MLAT + MCTX;
constexpr int DFF = 2816, INW = 5376, NMOD = 9;
constexpr float EPS = 1e-6f;
constexpr int NPH = 16;
constexpr int LDS_BYTES = 139264 + 16;

constexpr size_t MiB = 1u << 20;
constexpr size_t OFF_WFFN_IN = 0;
constexpr size_t OFF_WFFN_OUT = 11 * MiB;
constexpr size_t OFF_WMIX = 11 * MiB + 5632 * 1024;
constexpr size_t OFF_WOA = 27 * MiB;
constexpr size_t OFF_WOH = 28 * MiB;
constexpr size_t OFF_WOUT = 29 * MiB;
constexpr size_t OFF_MOD = 31 * MiB;
constexpr size_t OFF_ROPE = 31 * MiB + 640 * 1024;
constexpr size_t OFF_BAR = 32 * MiB;
constexpr size_t OFF_HA = 33 * MiB;
constexpr size_t OFF_ODIR = 33 * MiB;
constexpr size_t OFF_Y = 105 * MiB;
constexpr size_t OFF_QBUF = 105 * MiB;
constexpr size_t OFF_OR = 105 * MiB;
constexpr size_t OFF_KALL = 137 * MiB;
constexpr size_t OFF_VT = 146 * MiB;
constexpr size_t OFF_OATT = 155 * MiB;
constexpr size_t OFF_ACT = 177 * MiB;
constexpr size_t OFF_PART = 177 * MiB;
constexpr size_t OFF_HBUF = 187 * MiB;
constexpr size_t OFF_U = 187 * MiB;
constexpr size_t OFF_GBUF = 331 * MiB;
constexpr size_t OFF_X2 = 400 * MiB;

struct Params {
    const float *x, *c, *ctx, *c_ctx, *w_ada, *b_ada, *norm_pre, *norm_post, *ffn1_w_in, *ffn1_w_out, *ffn2_w_in, *ffn2_w_out,
        *mix_w_in, *attn_sink, *lb_fwd, *lb_bwd, *hgrn_norm, *w_o_attn, *w_o_hgrn, *w_out;
    float* out;
    unsigned char* ws;
};

typedef __bf16 bf16x2_t __attribute__((ext_vector_type(2)));
__device__ __forceinline__ unsigned cvt_pk_bf16(float lo, float hi) { bf16x2_t v; v[0] = (__bf16)lo; v[1] = (__bf16)hi; return __builtin_bit_cast(unsigned, v); }
__device__ __forceinline__ bf16_t f2bf(float f) { return __builtin_bit_cast(bf16_t, (__bf16)f); }
__device__ __forceinline__ float bf2f(bf16_t b) { return __uint_as_float(((unsigned)b) << 16); }
__device__ __forceinline__ float bflo(unsigned w) { return __uint_as_float(w << 16); }
__device__ __forceinline__ float bfhi(unsigned w) { return __uint_as_float(w & 0xffff0000u); }
__device__ __forceinline__ float sigmoidf_(float v) { return __builtin_amdgcn_rcpf(1.0f + __builtin_amdgcn_exp2f(v * -1.44269504f)); }
__device__ __forceinline__ float siluf_(float v) { return v * __builtin_amdgcn_rcpf(1.0f + __builtin_amdgcn_exp2f(v * -1.44269504f)); }
__device__ __forceinline__ float wave_sum(float v) {
#pragma unroll
    for (int o = 32; o >= 1; o >>= 1) v += __shfl_xor(v, o);
    return v;
}

constexpr int BM = 256, BK = 64, HALF = 128, HTB = HALF * BK * 2, NXCD = 8, WGM = 8;
__device__ __forceinline__ int lds_byte(int r, int c) { const int st = (r >> 4) * 2 + (c >> 5), rr = r & 15, cc = c & 31, ob = rr * 64 + cc * 2; return st * 1024 + (ob ^ (((ob >> 9) & 1) << 5)); }
__device__ __forceinline__ void stage_rc(int b, int& R, int& C) { const int st = b / 1024, sb = b % 1024, swz = sb ^ (((sb >> 9) & 1) << 5); R = (st >> 1) * 16 + swz / 64; C = (st & 1) * 32 + (swz % 64) / 2; }
__device__ __forceinline__ int perm32(int rho) { const int n = rho >> 4, i = rho & 15; return 8 * (i >> 2) + 4 * n + (i & 3); }

struct Unit { int pm, pn, part; };

__device__ __forceinline__ void rect_map(int Lidx, int nwg, int nM, int nN, int& pm, int& pn) {
    int wgid = Lidx;
    { const int q = nwg / NXCD, r = nwg % NXCD, xcd = wgid % NXCD, off = wgid / NXCD; wgid = (xcd < r ? xcd * (q + 1) : r * (q + 1) + (xcd - r) * q) + off; }
    const int nig = WGM * nN, gid = wgid / nig, fm = gid * WGM, gsz = (nM - fm) < WGM ? (nM - fm) : WGM;
    pm = fm + ((wgid % nig) % gsz); pn = (wgid % nig) / gsz;
}

struct RectOrder {
    const char *A, *B; int K, nM, nN, nwg, G, c, pm0;
    __device__ __forceinline__ bool next(int i, Unit& u) const {
        const int Lidx = i * G + c; if (Lidx >= nwg) return false;
        rect_map(Lidx, nwg, nM, nN, u.pm, u.pn); u.pm += pm0; u.part = 0; return true;
    }
    __device__ __forceinline__ const char* aptr(const Unit& u) const { return A + (size_t)u.pm * 512 * K; }
    __device__ __forceinline__ const char* bptr(const Unit& u) const { return B + (size_t)u.pn * 512 * K; }
};
struct MixOrder {
    const char *A, *B; int G, c;
    __device__ __forceinline__ bool next(int i, Unit& u) const {
        const int Lidx = i * G + c; if (Lidx >= 2800) return false;
        if (Lidx < 2688) rect_map(Lidx, 2688, 128, 21, u.pm, u.pn);
        else { const int j = Lidx - 2688, cs = j >> 4; u.pm = 128 + (j & 15); u.pn = cs == 0 ? 2 : 4 + cs; }
        u.part = 0; return true;
    }
    __device__ __forceinline__ const char* aptr(const Unit& u) const { return A + (size_t)u.pm * 512 * 1024; }
    __device__ __forceinline__ const char* bptr(const Unit& u) const { return B + (size_t)u.pn * 512 * 1024; }
};
struct MergeOrder {
    const char *A0, *B0, *A1, *B1; int G, c;
    __device__ __forceinline__ bool next(int i, Unit& u) const {
        const int Lidx = (i >> 1) * G + c; if (Lidx >= 512) return false;
        rect_map(Lidx, 512, 128, 4, u.pm, u.pn); u.part = i & 1; return true;
    }
    __device__ __forceinline__ const char* aptr(const Unit& u) const { return (u.part ? A1 : A0) + (size_t)u.pm * 512 * 512; }
    __device__ __forceinline__ const char* bptr(const Unit& u) const { return (u.part ? B1 : B0) + (size_t)u.pn * 512 * 512; }
};

typedef f32x4 Acc[2][2][4][2];

struct EpiSwiglu {
    static constexpr bool PERM = true;
    bf16_t* act;
    __device__ __forceinline__ bool operator()(Acc& acc, const Unit& u, int wr, int wc, int fr, int fq) const {
#pragma unroll
        for (int ai = 0; ai < 2; ++ai)
#pragma unroll
            for (int m = 0; m < 4; ++m) {
                const int r = u.pm * BM + ai * HALF + wr * 64 + m * 16 + fr;
                float v[8];
#pragma unroll
                for (int n = 0; n < 2; ++n)
#pragma unroll
                    for (int j = 0; j < 4; ++j) { const float g = acc[ai][0][m][n][j], up = acc[ai][1][m][n][j]; v[n * 4 + j] = (g * up) * __builtin_amdgcn_rcpf(1.0f + __builtin_amdgcn_exp2f(g * -1.44269504f)); }
                u32x4 w; w.x = cvt_pk_bf16(v[0], v[1]); w.y = cvt_pk_bf16(v[2], v[3]); w.z = cvt_pk_bf16(v[4], v[5]); w.w = cvt_pk_bf16(v[6], v[7]);
                *(u32x4*)(act + (size_t)r * DFF + u.pn * 128 + wc * 32 + fq * 8) = w;
            }
        return false;
    }
};
struct EpiBf16 {
    static constexpr bool PERM = true;
    bf16_t* C; int ldc;
    __device__ __forceinline__ bool operator()(Acc& acc, const Unit& u, int wr, int wc, int fr, int fq) const {
#pragma unroll
        for (int ai = 0; ai < 2; ++ai)
#pragma unroll
            for (int m = 0; m < 4; ++m) {
                const int r = u.pm * BM + ai * HALF + wr * 64 + m * 16 + fr;
#pragma unroll
                for (int bj = 0; bj < 2; ++bj) {
                    const f32x4 v0 = acc[ai][bj][m][0], v1 = acc[ai][bj][m][1];
                    u32x4 w; w.x = cvt_pk_bf16(v0[0], v0[1]); w.y = cvt_pk_bf16(v0[2], v0[3]); w.z = cvt_pk_bf16(v1[0], v1[1]); w.w = cvt_pk_bf16(v1[2], v1[3]);
                    *(u32x4*)(C + (size_t)r * ldc + u.pn * BM + bj * HALF + wc * 32 + fq * 8) = w;
                }
            }
        return false;
    }
};
struct EpiMerge {
    static constexpr bool PERM = true;
    const bf16_t* gbuf; bf16_t* U;
    __device__ __forceinline__ bool operator()(Acc& acc, const Unit& u, int wr, int wc, int fr, int fq) const {
        const bool first = u.part == 0;
        const int colb = u.pn * BM + wc * 32 + fq * 8;
        const int rowb = u.pm * BM + wr * 64 + fr;
        u32x4 ghc[2], gac[2], ghn[2], gan[2];
#define MG_LOAD(GH, GA, it) do { const int r_ = rowb + ((it) >> 2) * HALF + ((it) & 3) * 16; \
        _Pragma("unroll") for (int bj = 0; bj < 2; ++bj) { GH[bj] = *(const u32x4*)(gbuf + (size_t)r_ * 2560 + 1536 + colb + bj * HALF); \
            if (first) GA[bj] = *(const u32x4*)(gbuf + (size_t)r_ * 2560 + 512 + colb + bj * HALF); else GA[bj] = GH[bj]; } } while (0)
        MG_LOAD(ghc, gac, 0);
#pragma unroll
        for (int it = 0; it < 8; ++it) {
            const int ai = it >> 2, m = it & 3;
            if (it < 7) MG_LOAD(ghn, gan, it + 1);
            const int r = rowb + ai * HALF + m * 16;
#pragma unroll
            for (int bj = 0; bj < 2; ++bj) {
                if (first) {
#pragma unroll
                    for (int q = 0; q < 4; ++q) {
                        const float a0 = bflo(gac[bj][q]), a1 = bfhi(gac[bj][q]), h0 = bflo(ghc[bj][q]), h1 = bfhi(ghc[bj][q]);
                        const float r0 = (1.0f + __builtin_amdgcn_exp2f(h0 * -1.44269504f)) * __builtin_amdgcn_rcpf(1.0f + __builtin_amdgcn_exp2f(a0 * -1.44269504f));
                        const float r1 = (1.0f + __builtin_amdgcn_exp2f(h1 * -1.44269504f)) * __builtin_amdgcn_rcpf(1.0f + __builtin_amdgcn_exp2f(a1 * -1.44269504f));
                        acc[ai][bj][m][q >> 1][(q & 1) * 2] *= r0; acc[ai][bj][m][q >> 1][(q & 1) * 2 + 1] *= r1;
                    }
                } else {
                    float v[8];
#pragma unroll
                    for (int q = 0; q < 4; ++q) {
                        const float h0 = bflo(ghc[bj][q]), h1 = bfhi(ghc[bj][q]);
                        v[q * 2] = acc[ai][bj][m][q >> 1][(q & 1) * 2] * sigmoidf_(h0); v[q * 2 + 1] = acc[ai][bj][m][q >> 1][(q & 1) * 2 + 1] * sigmoidf_(h1);
                    }
                    u32x4 w; w.x = cvt_pk_bf16(v[0], v[1]); w.y = cvt_pk_bf16(v[2], v[3]); w.z = cvt_pk_bf16(v[4], v[5]); w.w = cvt_pk_bf16(v[6], v[7]);
                    *(u32x4*)(U + (size_t)r * D + colb + bj * HALF) = w;
                }
            }
#pragma unroll
            for (int bj = 0; bj < 2; ++bj) { ghc[bj] = ghn[bj]; gac[bj] = gan[bj]; }
        }
#undef MG_LOAD
        return first;
    }
};
struct EpiMixIn {
    static constexpr bool PERM = true;
    bf16_t *qbuf, *kall, *vt, *hbuf, *gbuf; const LAS float2* rope;
    __device__ __forceinline__ bool operator()(Acc& acc, const Unit& u, int wr, int wc, int fr, int fq) const {
        const int pn = u.pn;
        const int rowb = u.pm * BM + wr * 64 + fr;
        if (pn <= 2) {
            const bool lat = u.pm < 128;
#pragma unroll
            for (int ai = 0; ai < 2; ++ai) {
            float2 cs[4][4];
#pragma unroll
            for (int it = 0; it < 4; ++it) {
                const int r = rowb + ai * HALF + it * 16;
                const int t = r & (T - 1), pos = (wc & 1) ? (t & 63) : (t >> 6);
#pragma unroll
                for (int j = 0; j < 4; ++j) { const LAS float* rp_ = (const LAS float*)(rope + pos * 16 + fq * 4 + j); cs[it][j] = lat ? make_float2(rp_[0], rp_[1]) : make_float2(1.0f, 0.0f); }
            }
#pragma unroll
            for (int it = 0; it < 4; ++it) {
                const int m = it;
                const int r = rowb + ai * HALF + m * 16;
                if (pn < 2) {
#pragma unroll
                    for (int bj = 0; bj < 2; ++bj) {
                        const f32x4 x1 = acc[ai][bj][m][0], x2 = acc[ai][bj][m][1];
                        float o1[4], o2[4];
#pragma unroll
                        for (int j = 0; j < 4; ++j) { o1[j] = (x1[j] * cs[it][j].x - x2[j] * cs[it][j].y) * 0.18033688f; o2[j] = (x1[j] * cs[it][j].y + x2[j] * cs[it][j].x) * 0.18033688f; }
                        bf16_t* dst = qbuf + (size_t)r * 512 + pn * 256 + bj * 128 + wc * 32 + fq * 4;
                        u32x2 w0, w1; w0.x = cvt_pk_bf16(o1[0], o1[1]); w0.y = cvt_pk_bf16(o1[2], o1[3]); w1.x = cvt_pk_bf16(o2[0], o2[1]); w1.y = cvt_pk_bf16(o2[2], o2[3]);
                        *(u32x2*)dst = w0; *(u32x2*)(dst + 16) = w1;
                    }
                } else {
                    const int b = lat ? (r >> 11) : ((r - MLAT) >> 8);
                    const int tpos = lat ? (r & (T - 1)) : (T + ((r - MLAT) & (L - 1)));
                    const int kvh = wc >> 1;
                    f32x4 x1 = acc[ai][0][m][0], x2 = acc[ai][0][m][1];
#pragma unroll
                    for (int j = 0; j < 4; ++j) { const float a = x1[j], bb = x2[j]; x1[j] = a * cs[it][j].x - bb * cs[it][j].y; x2[j] = a * cs[it][j].y + bb * cs[it][j].x; }
                    bf16_t* kd = kall + ((size_t)(b * 2 + kvh) * 2304 + tpos) * 64 + (wc & 1) * 32 + fq * 4;
                    u32x2 w0, w1; w0.x = cvt_pk_bf16(x1[0], x1[1]); w0.y = cvt_pk_bf16(x1[2], x1[3]); w1.x = cvt_pk_bf16(x2[0], x2[1]); w1.y = cvt_pk_bf16(x2[2], x2[3]);
                    *(u32x2*)kd = w0; *(u32x2*)(kd + 16) = w1;
                    const f32x4 v1 = acc[ai][1][m][0], v2 = acc[ai][1][m][1];
                    bf16_t* vd = vt + ((size_t)(b * 2 + kvh) * 64 + (wc & 1) * 32 + fq * 8) * 2304 + tpos;
#pragma unroll
                    for (int j = 0; j < 4; ++j) { vd[(size_t)j * 2304] = f2bf(v1[j]); vd[(size_t)(j + 4) * 2304] = f2bf(v2[j]); }
                }
            }
            }
        } else if (pn <= 4) {
#pragma unroll
            for (int ai = 0; ai < 2; ++ai)
#pragma unroll
                for (int m = 0; m < 4; ++m) {
                    const int r = rowb + ai * HALF + m * 16;
                    bf16_t* dst = hbuf + (size_t)r * 2048 + (pn - 3) * 256;
#pragma unroll
                    for (int bj = 0; bj < 2; ++bj) {
                        const f32x4 v0 = acc[ai][bj][m][0], v1 = acc[ai][bj][m][1];
                        u32x4 w; w.x = cvt_pk_bf16(siluf_(v0[0]), siluf_(v0[1])); w.y = cvt_pk_bf16(siluf_(v0[2]), siluf_(v0[3]));
                        w.z = cvt_pk_bf16(siluf_(v1[0]), siluf_(v1[1])); w.w = cvt_pk_bf16(siluf_(v1[2]), siluf_(v1[3]));
                        *(u32x4*)(dst + bj * 128 + wc * 32 + fq * 8) = w;
                    }
                }
        } else {
#pragma unroll
            for (int ai = 0; ai < 2; ++ai)
#pragma unroll
                for (int m = 0; m < 4; ++m) {
                    const int r = rowb + ai * HALF + m * 16;
                    bf16_t* dst = pn < 11 ? hbuf + (size_t)r * 2048 + (pn - 3) * 256 : gbuf + (size_t)r * 2560 + (pn - 11) * 256;
#pragma unroll
                    for (int bj = 0; bj < 2; ++bj) {
                        const f32x4 v0 = acc[ai][bj][m][0], v1 = acc[ai][bj][m][1];
                        u32x4 w; w.x = cvt_pk_bf16(v0[0], v0[1]); w.y = cvt_pk_bf16(v0[2], v0[3]); w.z = cvt_pk_bf16(v1[0], v1[1]); w.w = cvt_pk_bf16(v1[2], v1[3]);
                        *(u32x4*)(dst + bj * 128 + wc * 32 + fq * 8) = w;
                    }
                }
        }
        return false;
    }
};

template <class Epi, class Sched>
__device__ __forceinline__ void gemm_phase(LAS unsigned char* lds, const int K, const Sched& S, const Epi& E, const int tid) {
    const int wid = __builtin_amdgcn_readfirstlane(tid >> 6), lane = tid & 63, wr = wid >> 2, wc = wid & 3, fr = lane & 15, fq = lane >> 4;
    const int nt = K / BK;
    unsigned voffA[2], voffB[2];
#pragma unroll
    for (int i = 0; i < 2; ++i) { int R, C; stage_rc(tid * 16 + i * 8192, R, C); const int Rb = Epi::PERM ? ((R & ~31) + perm32(R & 31)) : R;
        voffA[i] = (unsigned)(R * K + C) * 2u; voffB[i] = (unsigned)(Rb * K + C) * 2u; }
    const size_t kstep = (size_t)(BK * 2);
    const size_t hstep = (size_t)HALF * K * 2;
    const unsigned ldsw = (unsigned)wid * 1024u;
    const int aoff = lds_byte(wr * 64 + fr, fq * 8), boff = lds_byte(wc * 32 + fr, fq * 8);
#define PG8_SA(b, h) (((b) * 2 + (h)) * HTB)
#define PG8_SB(b, h) ((4 + (b) * 2 + (h)) * HTB)
#define PG8_STAGE(bufoff, gbase, voff) do { _Pragma("unroll") for (int _i = 0; _i < 2; ++_i) \
        __builtin_amdgcn_global_load_lds((const unsigned*)((const char*)(gbase) + (voff)[_i]), (LAS unsigned*)(lds + (bufoff) + ldsw + _i * 8192), 16, 0, 0); } while (0)
#define PG8_LDA(dst, b, h) do { _Pragma("unroll") for (int m = 0; m < 4; ++m) _Pragma("unroll") for (int k = 0; k < 2; ++k) dst[m][k] = *(const LAS bf16x8*)(lds + PG8_SA(b, h) + aoff + m * 2048 + k * 1024); } while (0)
#define PG8_LDB(dst, b, h) do { _Pragma("unroll") for (int n = 0; n < 2; ++n) _Pragma("unroll") for (int k = 0; k < 2; ++k) dst[n][k] = *(const LAS bf16x8*)(lds + PG8_SB(b, h) + boff + n * 2048 + k * 1024); } while (0)
#define PG8_MMA(ai, bj, At, Bt) do { __builtin_amdgcn_s_setprio(1); _Pragma("unroll") for (int m = 0; m < 4; ++m) _Pragma("unroll") for (int n = 0; n < 2; ++n) _Pragma("unroll") for (int k = 0; k < 2; ++k) \
        acc[ai][bj][m][n] = __builtin_amdgcn_mfma_f32_16x16x32_bf16(Bt[n][k], At[m][k], acc[ai][bj][m][n], 0, 0, 0); __builtin_amdgcn_s_setprio(0); } while (0)
#define PG8_WAIT_V(n) asm volatile("s_waitcnt vmcnt(" #n ")" ::: "memory")
#define PG8_WAIT_L(n) asm volatile("s_waitcnt lgkmcnt(" #n ")" ::: "memory")
#define PG8_BAR __builtin_amdgcn_s_barrier()
#define PG8_SCHED __builtin_amdgcn_sched_barrier(0)
    Unit cur, nxt; int ui = 0;
    if (!S.next(0, cur)) return;
    Acc acc;
#pragma unroll
    for (int a = 0; a < 2; ++a)
#pragma unroll
        for (int b = 0; b < 2; ++b)
#pragma unroll
            for (int m = 0; m < 4; ++m)
#pragma unroll
                for (int n = 0; n < 2; ++n) acc[a][b][m][n] = (f32x4){0.f, 0.f, 0.f, 0.f};
    bf16x8 At[4][2], B0[2][2], B1[2][2];
    const char* cA = S.aptr(cur); const char* cB = S.bptr(cur);
    PG8_STAGE(PG8_SB(0, 0), cB, voffB); PG8_STAGE(PG8_SA(0, 0), cA, voffA); PG8_STAGE(PG8_SB(0, 1), cB + hstep, voffB); PG8_STAGE(PG8_SA(0, 1), cA + hstep, voffA);
    if (wr == 1) PG8_BAR;
    PG8_WAIT_V(4); PG8_BAR;
    PG8_STAGE(PG8_SB(1, 0), cB + kstep, voffB); PG8_STAGE(PG8_SA(1, 0), cA + kstep, voffA); PG8_STAGE(PG8_SB(1, 1), cB + hstep + kstep, voffB);
    PG8_WAIT_V(6); PG8_BAR;
    for (;;) {
        const bool has_next = S.next(ui + 1, nxt);
        const char* nA = has_next ? S.aptr(nxt) : cA; const char* nB = has_next ? S.bptr(nxt) : cB;
        for (int t = 0; t < nt; t += 2) {
            const bool last = (t == nt - 2);
            const char* a1 = cA + (size_t)(t + 1) * kstep;
            const char* a2 = last ? nA : cA + (size_t)(t + 2) * kstep; const char* b2 = last ? nB : cB + (size_t)(t + 2) * kstep;
            const char* a3 = a2 + kstep; const char* b3 = b2 + kstep;
            PG8_LDB(B0, 0, 0); PG8_SCHED; PG8_LDA(At, 0, 0); PG8_STAGE(PG8_SA(1, 1), a1 + hstep, voffA);
            PG8_WAIT_L(8); PG8_BAR; PG8_WAIT_L(0); PG8_MMA(0, 0, At, B0); PG8_BAR; PG8_SCHED;
            PG8_LDB(B1, 0, 1); PG8_STAGE(PG8_SB(0, 0), b2, voffB);
            PG8_BAR; PG8_WAIT_L(0); PG8_MMA(0, 1, At, B1); PG8_BAR;
            PG8_LDA(At, 0, 1); PG8_STAGE(PG8_SA(0, 0), a2, voffA);
            PG8_BAR; PG8_WAIT_L(0); PG8_MMA(1, 0, At, B0); PG8_BAR; PG8_SCHED;
            PG8_STAGE(PG8_SB(0, 1), b2 + hstep, voffB);
            PG8_WAIT_V(6); PG8_BAR; PG8_MMA(1, 1, At, B1); PG8_BAR;
            PG8_LDB(B0, 1, 0); PG8_SCHED; PG8_LDA(At, 1, 0); PG8_STAGE(PG8_SA(0, 1), a2 + hstep, voffA);
            PG8_WAIT_L(8); PG8_BAR; PG8_WAIT_L(0); PG8_MMA(0, 0, At, B0); PG8_BAR; PG8_SCHED;
            PG8_LDB(B1, 1, 1); PG8_STAGE(PG8_SB(1, 0), b3, voffB);
            PG8_BAR; PG8_WAIT_L(0); PG8_MMA(0, 1, At, B1); PG8_BAR;
            PG8_LDA(At, 1, 1); PG8_STAGE(PG8_SA(1, 0), a3, voffA);
            PG8_BAR; PG8_WAIT_L(0); PG8_MMA(1, 0, At, B0); PG8_BAR; PG8_SCHED;
            PG8_STAGE(PG8_SB(1, 1), b3 + hstep, voffB);
            PG8_WAIT_V(6); PG8_BAR; PG8_MMA(1, 1, At, B1); PG8_BAR;
        }
        const bool keep = E(acc, cur, wr, wc, fr, fq);
        if (!has_next) break;
        if (!keep) {
#pragma unroll
            for (int a = 0; a < 2; ++a)
#pragma unroll
                for (int b = 0; b < 2; ++b)
#pragma unroll
                    for (int m = 0; m < 4; ++m)
#pragma unroll
                        for (int n = 0; n < 2; ++n) acc[a][b][m][n] = (f32x4){0.f, 0.f, 0.f, 0.f};
        }
        cur = nxt; cA = nA; cB = nB; ++ui;
    }
    PG8_WAIT_V(0);
    if (wr == 0) PG8_BAR;
    PG8_BAR;
#undef PG8_SA
#undef PG8_SB
#undef PG8_STAGE
#undef PG8_LDA
#undef PG8_LDB
#undef PG8_MMA
#undef PG8_WAIT_V
#undef PG8_WAIT_L
#undef PG8_BAR
#undef PG8_SCHED
}

struct TileDesc { const float* W; bf16_t* Bt; int K, N, mapmode, tile; };
__device__ __forceinline__ TileDesc tile_desc(const Params& p, unsigned char* ws, int t, int set) {
    TileDesc d;
    if (set == 0) {
        if (t < 1408) { d.W = p.ffn1_w_in; d.Bt = (bf16_t*)(ws + OFF_WFFN_IN); d.K = D; d.N = 2 * DFF; d.mapmode = 1; d.tile = t; }
        else if ((t -= 1408) < 704) { d.W = p.ffn1_w_out; d.Bt = (bf16_t*)(ws + OFF_WFFN_OUT); d.K = DFF; d.N = D; d.mapmode = 0; d.tile = t; }
        else if ((t -= 704) < 1344) { d.W = p.mix_w_in; d.Bt = (bf16_t*)(ws + OFF_WMIX); d.K = D; d.N = INW; d.mapmode = 2; d.tile = t; }
        else if ((t -= 1344) < 128) { d.W = p.w_o_attn; d.Bt = (bf16_t*)(ws + OFF_WOA); d.K = 512; d.N = D; d.mapmode = 0; d.tile = t; }
        else if ((t -= 128) < 128) { d.W = p.w_o_hgrn; d.Bt = (bf16_t*)(ws + OFF_WOH); d.K = 512; d.N = D; d.mapmode = 0; d.tile = t; }
        else { t -= 128; d.W = p.w_out; d.Bt = (bf16_t*)(ws + OFF_WOUT); d.K = D; d.N = D; d.mapmode = 0; d.tile = t; }
    } else {
        if (t < 1408) { d.W = p.ffn2_w_in; d.Bt = (bf16_t*)(ws + OFF_WFFN_IN); d.K = D; d.N = 2 * DFF; d.mapmode = 1; d.tile = t; }
        else { d.W = p.ffn2_w_out; d.Bt = (bf16_t*)(ws + OFF_WFFN_OUT); d.K = DFF; d.N = D; d.mapmode = 0; d.tile = t - 1408; }
    }
    return d;
}
__device__ __forceinline__ void convert_tiles(const Params& p, unsigned char* ws, int set, int ntiles, int first, int stride, LAS float* tl, int tid) {
    if (first >= ntiles) return;
    const int kk = tid >> 4, n4 = (tid & 15) * 4;
#define TILE_LOAD(dsc, A0, A1) do { const int ntn_ = (dsc).N >> 6, tk_ = (dsc).tile / ntn_, tn_ = (dsc).tile - tk_ * ntn_; \
        const float* src_ = (dsc).W + (size_t)(tk_ * 64 + kk) * (dsc).N + tn_ * 64 + n4; A0 = *(const f32x4*)src_; A1 = *(const f32x4*)(src_ + (size_t)32 * (dsc).N); } while (0)
#define CV_BAR() do { asm volatile("s_waitcnt lgkmcnt(0)" ::: "memory"); __builtin_amdgcn_s_barrier(); asm volatile("" ::: "memory"); } while (0)
    TileDesc cur = tile_desc(p, ws, first, set); f32x4 v0, v1; TILE_LOAD(cur, v0, v1);
    for (int t = first; t < ntiles; t += stride) {
        TileDesc nxt = cur; f32x4 n0 = v0, n1 = v1;
        if (t + stride < ntiles) { nxt = tile_desc(p, ws, t + stride, set); TILE_LOAD(nxt, n0, n1); }
#pragma unroll
        for (int j = 0; j < 4; ++j) { tl[kk * 65 + n4 + j] = v0[j]; tl[(kk + 32) * 65 + n4 + j] = v1[j]; }
        CV_BAR();
        {
            const int ntn = cur.N >> 6, tk = cur.tile / ntn, tn = cur.tile - tk * ntn, k0 = tk * 64, n0c = tn * 64;
            const int n = tid >> 3, ks = tid & 7; float v[8];
#pragma unroll
            for (int j = 0; j < 8; ++j) v[j] = tl[(ks * 8 + j) * 65 + n];
            int col = n0c + n, row = col;
            if (cur.mapmode == 1) { const int bj = col >= DFF ? 1 : 0, rem = col - bj * DFF; row = (rem >> 7) * 256 + bj * 128 + (rem & 127); }
            if (cur.mapmode == 2 && col < 640) { const int i32 = col & 31; row = (col & ~31) + 8 * ((i32 >> 2) & 3) + 4 * (i32 >> 4) + (i32 & 3); }
            u32x4 w; w.x = cvt_pk_bf16(v[0], v[1]); w.y = cvt_pk_bf16(v[2], v[3]); w.z = cvt_pk_bf16(v[4], v[5]); w.w = cvt_pk_bf16(v[6], v[7]);
            *(u32x4*)(cur.Bt + (size_t)row * cur.K + k0 + ks * 8) = w;
        }
        CV_BAR();
        cur = nxt; v0 = n0; v1 = n1;
    }
    __syncthreads();
#undef TILE_LOAD
#undef CV_BAR
}

__device__ __forceinline__ void mod_partial_item(const Params& p, int item, LAS float* sl, int tid) {
    const int ks = item / 18, chunk = item - ks * 18, col = chunk * 512 + tid;
    for (int i = tid; i < 17 * 64; i += 512) { const int b = i >> 6, kk = i & 63; const float cv = b < 16 ? p.c[b * D + ks * 64 + kk] : p.c_ctx[ks * 64 + kk]; sl[i] = siluf_(cv); }
    __syncthreads();
    float acc[17];
#pragma unroll
    for (int b = 0; b < 17; ++b) acc[b] = 0.f;
    const float* w = p.w_ada + (size_t)(ks * 64) * (NMOD * D) + col;
    for (int k0 = 0; k0 < 64; k0 += 16) {
        float wv[16];
#pragma unroll
        for (int j = 0; j < 16; ++j) wv[j] = w[(size_t)(k0 + j) * (NMOD * D)];
#pragma unroll
        for (int j = 0; j < 16; ++j)
#pragma unroll
            for (int b = 0; b < 17; ++b) acc[b] += sl[b * 64 + k0 + j] * wv[j];
    }
    float* part = (float*)(p.ws + OFF_PART);
#pragma unroll
    for (int b = 0; b < 17; ++b) part[(size_t)(ks * 17 + b) * (NMOD * D) + col] = acc[b];
    __syncthreads();
}

__device__ __forceinline__ void row_op(const float* src, const bf16_t* y, float w, const float* gate, const float* gpost, float* xdst,
                                       const float* gpre, const float* shift, const float* scale, bf16_t* hdst, int lane) {
    f32x4 v[4];
#pragma unroll
    for (int i = 0; i < 4; ++i) v[i] = *(const f32x4*)(src + i * 256 + lane * 4);
    if (y) {
        f32x4 yv[4]; float ss = 0.f;
#pragma unroll
        for (int i = 0; i < 4; ++i) { const u32x2 raw = *(const u32x2*)(y + i * 256 + lane * 4); yv[i] = (f32x4){bflo(raw.x), bfhi(raw.x), bflo(raw.y), bfhi(raw.y)};
            ss += yv[i][0] * yv[i][0] + yv[i][1] * yv[i][1] + yv[i][2] * yv[i][2] + yv[i][3] * yv[i][3]; }
        ss = wave_sum(ss);
        const float rstd = rsqrtf(ss * (1.0f / D) + EPS);
#pragma unroll
        for (int i = 0; i < 4; ++i) { const f32x4 g = *(const f32x4*)(gate + i * 256 + lane * 4), gp = *(const f32x4*)(gpost + i * 256 + lane * 4);
            v[i] = v[i] + (w * g) * ((yv[i] * rstd) * gp); }
        if (xdst) {
#pragma unroll
            for (int i = 0; i < 4; ++i) *(f32x4*)(xdst + i * 256 + lane * 4) = v[i];
        }
    }
    if (hdst) {
        float ss = 0.f;
#pragma unroll
        for (int i = 0; i < 4; ++i) ss += v[i][0] * v[i][0] + v[i][1] * v[i][1] + v[i][2] * v[i][2] + v[i][3] * v[i][3];
        ss = wave_sum(ss);
        const float rstd = rsqrtf(ss * (1.0f / D) + EPS);
#pragma unroll
        for (int i = 0; i < 4; ++i) { const f32x4 g = *(const f32x4*)(gpre + i * 256 + lane * 4), sh = *(const f32x4*)(shift + i * 256 + lane * 4), sc = *(const f32x4*)(scale + i * 256 + lane * 4);
            const f32x4 h = ((v[i] * rstd) * g) * (1.0f + sc) + sh;
            u32x2 o; o.x = cvt_pk_bf16(h[0], h[1]); o.y = cvt_pk_bf16(h[2], h[3]);
            *(u32x2*)(hdst + i * 256 + lane * 4) = o; }
    }
}

template <bool HASY, bool HASH, bool SRCBF, int XMODE>
__device__ __forceinline__ void rows_phase(const float* mod, int r0, int r1, const float* srcLat, const float* srcCtx, const bf16_t* srcB, const bf16_t* ybuf, float w, int gate_j,
                                           const float* gpost, void* xdst, const float* gpre, int shift_j, bf16_t* hdst, int lane) {
    f32x4 PA[4], PB[4], PC[4];
    f32x4 cv[4], nv[4]; u32x2 cy[4], ny[4];
    int curb = -1;
#define ROW_LOAD(V, Y, r) do { \
        if (SRCBF) { _Pragma("unroll") for (int i = 0; i < 4; ++i) { const u32x2 raw_ = *(const u32x2*)(srcB + (size_t)(r) * D + i * 256 + lane * 4); V[i] = (f32x4){bflo(raw_.x), bfhi(raw_.x), bflo(raw_.y), bfhi(raw_.y)}; } } \
        else { const float* sp_ = (r) < MLAT ? srcLat + (size_t)(r) * D : srcCtx + (size_t)((r) - MLAT) * D; \
            _Pragma("unroll") for (int i = 0; i < 4; ++i) V[i] = *(const f32x4*)(sp_ + i * 256 + lane * 4); } \
        if (HASY) { _Pragma("unroll") for (int i = 0; i < 4; ++i) Y[i] = *(const u32x2*)(ybuf + (size_t)(r) * D + i * 256 + lane * 4); } } while (0)
    ROW_LOAD(cv, cy, r0);
    f32x4 sxf[4]; u32x2 sxb[4], shb[4]; int rs = -1;
#define ROW_STORE() do { if (rs >= 0) { \
        if (HASY && XMODE == 2) { _Pragma("unroll") for (int i = 0; i < 4; ++i) *(f32x4*)((float*)xdst + (size_t)rs * D + i * 256 + lane * 4) = sxf[i]; } \
        if (HASY && XMODE == 1 && rs < MLAT) { _Pragma("unroll") for (int i = 0; i < 4; ++i) *(u32x2*)((bf16_t*)xdst + (size_t)rs * D + i * 256 + lane * 4) = sxb[i]; } \
        if (HASH) { _Pragma("unroll") for (int i = 0; i < 4; ++i) *(u32x2*)(hdst + (size_t)rs * D + i * 256 + lane * 4) = shb[i]; } } } while (0)
    for (int r = r0; r < r1; ++r) {
        ROW_STORE();
        if (r + 1 < r1) ROW_LOAD(nv, ny, r + 1);
        const int bb = r < MLAT ? (r >> 11) : 16;
        if (bb != curb) {
            curb = bb;
            const float* mr = mod + (size_t)bb * NMOD * D;
#pragma unroll
            for (int i = 0; i < 4; ++i) {
                const int cix = i * 256 + lane * 4;
                if (HASY) PA[i] = (*(const f32x4*)(mr + gate_j * D + cix) * w) * *(const f32x4*)(gpost + cix);
                if (HASH) { PB[i] = *(const f32x4*)(gpre + cix) * (1.0f + *(const f32x4*)(mr + (shift_j + 1) * D + cix)); PC[i] = *(const f32x4*)(mr + shift_j * D + cix); }
            }
        }
        if (HASY) {
            f32x4 yv[4]; float ss = 0.f;
#pragma unroll
            for (int i = 0; i < 4; ++i) { yv[i] = (f32x4){bflo(cy[i].x), bfhi(cy[i].x), bflo(cy[i].y), bfhi(cy[i].y)};
                ss += yv[i][0] * yv[i][0] + yv[i][1] * yv[i][1] + yv[i][2] * yv[i][2] + yv[i][3] * yv[i][3]; }
            ss = wave_sum(ss);
            const float rstd = rsqrtf(ss * (1.0f / D) + EPS);
#pragma unroll
            for (int i = 0; i < 4; ++i) cv[i] = cv[i] + PA[i] * (yv[i] * rstd);
            if (XMODE == 2) {
#pragma unroll
                for (int i = 0; i < 4; ++i) sxf[i] = cv[i];
            }
            if (XMODE == 1) {
#pragma unroll
                for (int i = 0; i < 4; ++i) { u32x2 o; o.x = cvt_pk_bf16(cv[i][0], cv[i][1]); o.y = cvt_pk_bf16(cv[i][2], cv[i][3]); sxb[i] = o;
                    if (r < MLAT) cv[i] = (f32x4){bflo(o.x), bfhi(o.x), bflo(o.y), bfhi(o.y)}; }
            }
        }
        if (HASH) {
            float ss = 0.f;
#pragma unroll
            for (int i = 0; i < 4; ++i) ss += cv[i][0] * cv[i][0] + cv[i][1] * cv[i][1] + cv[i][2] * cv[i][2] + cv[i][3] * cv[i][3];
            ss = wave_sum(ss);
            const float rstd = rsqrtf(ss * (1.0f / D) + EPS);
#pragma unroll
            for (int i = 0; i < 4; ++i) { const f32x4 h = (cv[i] * rstd) * PB[i] + PC[i];
                u32x2 o; o.x = cvt_pk_bf16(h[0], h[1]); o.y = cvt_pk_bf16(h[2], h[3]); shb[i] = o; }
        }
        rs = r;
#pragma unroll
        for (int i = 0; i < 4; ++i) { cv[i] = nv[i]; cy[i] = ny[i]; }
    }
    ROW_STORE();
#undef ROW_STORE
#undef ROW_LOAD
}

constexpr int AT_NS = 4, AT_STAGE = 8192;
__device__ __forceinline__ void attn_item(const Params& p, int item, int tid, LAS unsigned char* lds) {
    const bf16_t* qbuf = (const bf16_t*)(p.ws + OFF_QBUF);
    const bf16_t* kall = (const bf16_t*)(p.ws + OFF_KALL);
    const bf16_t* vtall = (const bf16_t*)(p.ws + OFF_VT);
    bf16_t* oatt = (bf16_t*)(p.ws + OFF_OATT);
    const int wid = __builtin_amdgcn_readfirstlane(tid >> 6), lane = tid & 63;
    const int qb = item & 15, kvh = (item >> 4) & 1, b = item >> 5;
    const int g = wid >> 1, qh = wid & 1, head = kvh * 4 + g, q0 = qb * 128 + qh * 64;
    const int fr = lane & 15, fq = lane >> 4;
    const bf16_t* Kp = kall + (size_t)(b * 2 + kvh) * 2304 * 64;
    const bf16_t* Vp = vtall + (size_t)(b * 2 + kvh) * 64 * 2304;
    const int blo = qb * 128 - 128 < 0 ? 0 : qb * 128 - 128, bhi = qb * 128 + 256 > T ? T : qb * 128 + 256;
    const int nbb = (bhi - blo) >> 5, ntile = nbb + 8;
    const int wlo = q0 - 128 < 0 ? 0 : q0 - 128, whi = q0 + 192 > T ? T : q0 + 192;
    const char* src; int tile_step;
    if (wid < 4) { const int key = tid >> 3, pc = tid & 7, ch = pc ^ (key & 7); src = (const char*)(Kp + (size_t)key * 64 + ch * 8); tile_step = 32 * 64 * 2; }
    else { const int j = tid - 256, row = j >> 2, pc = j & 3, ch = pc ^ ((row >> 2) & 3); src = (const char*)(Vp + (size_t)row * 2304 + ch * 8); tile_step = 32 * 2; }
    const unsigned ldsw = (unsigned)wid * 1024u;
#define AT_ISSUE(t) do { const int tt_ = (t) < ntile ? (t) : ntile - 1; const int k0_ = tt_ < nbb ? blo + tt_ * 32 : T + (tt_ - nbb) * 32; \
        __builtin_amdgcn_global_load_lds((const unsigned*)(src + (size_t)(k0_ >> 5) * tile_step), (LAS unsigned*)(lds + ((t) & (AT_NS - 1)) * AT_STAGE + ldsw), 16, 0, 0); } while (0)
    asm volatile("s_waitcnt lgkmcnt(0)" ::: "memory"); __builtin_amdgcn_s_barrier(); asm volatile("" ::: "memory");
    AT_ISSUE(0); AT_ISSUE(1); AT_ISSUE(2);
    bf16x8 qf[4][2];
#pragma unroll
    for (int qt = 0; qt < 4; ++qt)
#pragma unroll
        for (int kk = 0; kk < 2; ++kk) qf[qt][kk] = *(const bf16x8*)(qbuf + (size_t)(b * T + q0 + qt * 16 + fr) * 512 + head * 64 + kk * 32 + fq * 8);
    f32x4 o[4][4]; float mrun[4], lrun[4];
#pragma unroll
    for (int qt = 0; qt < 4; ++qt) { mrun[qt] = -1e30f; lrun[qt] = 0.f;
#pragma unroll
        for (int dt = 0; dt < 4; ++dt) o[qt][dt] = (f32x4){0.f, 0.f, 0.f, 0.f}; }
    asm volatile("s_waitcnt vmcnt(0)" ::: "memory");
    for (int it = 0; it < ntile; ++it) {
        if (it > 0) asm volatile("s_waitcnt vmcnt(2)" ::: "memory");
        __builtin_amdgcn_s_barrier(); asm volatile("" ::: "memory");
        AT_ISSUE(it + 3);
        const bool band = it < nbb;
        const int key0 = band ? blo + it * 32 : T + (it - nbb) * 32;
        if (band && (key0 < wlo || key0 >= whi)) continue;
        const LAS unsigned char* st = lds + (it & (AT_NS - 1)) * AT_STAGE;
        bf16x8 kf[2][2];
#pragma unroll
        for (int kt = 0; kt < 2; ++kt)
#pragma unroll
            for (int kk = 0; kk < 2; ++kk) { const int key = kt * 16 + fr, ch = kk * 4 + fq; kf[kt][kk] = *(const LAS bf16x8*)(st + key * 128 + ((ch ^ (key & 7)) << 4)); }
        bf16x8 vf[4];
#pragma unroll
        for (int dt = 0; dt < 4; ++dt) {
            const int row = dt * 16 + fr, sw = (row >> 2) & 3;
            const u32x2 lo = *(const LAS u32x2*)(st + 4096 + row * 64 + (((fq >> 1) ^ sw) << 4) + (fq & 1) * 8);
            const u32x2 hi = *(const LAS u32x2*)(st + 4096 + row * 64 + (((2 + (fq >> 1)) ^ sw) << 4) + (fq & 1) * 8);
            u32x4 w; w.x = lo.x; w.y = lo.y; w.z = hi.x; w.w = hi.y;
            vf[dt] = __builtin_bit_cast(bf16x8, w);
        }
        f32x4 sc[4][2];
#pragma unroll
        for (int qt = 0; qt < 4; ++qt) {
            f32x4 s0 = (f32x4){0.f, 0.f, 0.f, 0.f}, s1 = (f32x4){0.f, 0.f, 0.f, 0.f};
            s0 = __builtin_amdgcn_mfma_f32_16x16x32_bf16(kf[0][0], qf[qt][0], s0, 0, 0, 0);
            s0 = __builtin_amdgcn_mfma_f32_16x16x32_bf16(kf[0][1], qf[qt][1], s0, 0, 0, 0);
            s1 = __builtin_amdgcn_mfma_f32_16x16x32_bf16(kf[1][0], qf[qt][0], s1, 0, 0, 0);
            s1 = __builtin_amdgcn_mfma_f32_16x16x32_bf16(kf[1][1], qf[qt][1], s1, 0, 0, 0);
            sc[qt][0] = s0; sc[qt][1] = s1;
        }
        float mx[4];
#pragma unroll
        for (int qt = 0; qt < 4; ++qt)
            mx[qt] = fmaxf(fmaxf(fmaxf(sc[qt][0][0], sc[qt][0][1]), fmaxf(sc[qt][0][2], sc[qt][0][3])), fmaxf(fmaxf(sc[qt][1][0], sc[qt][1][1]), fmaxf(sc[qt][1][2], sc[qt][1][3])));
        const bool needmask = band && (key0 - q0 < -65 || key0 - q0 > 97);
        if (needmask) {
            const int dbase = key0 + fq * 4 - (q0 + fr);
#pragma unroll
            for (int qt = 0; qt < 4; ++qt) {
#pragma unroll
                for (int r = 0; r < 4; ++r) {
                    const int d0 = dbase + r - qt * 16, d1 = d0 + 16;
                    sc[qt][0][r] = (d0 > 128 || d0 < -128) ? -1e30f : sc[qt][0][r];
                    sc[qt][1][r] = (d1 > 128 || d1 < -128) ? -1e30f : sc[qt][1][r];
                }
                mx[qt] = fmaxf(fmaxf(fmaxf(sc[qt][0][0], sc[qt][0][1]), fmaxf(sc[qt][0][2], sc[qt][0][3])), fmaxf(fmaxf(sc[qt][1][0], sc[qt][1][1]), fmaxf(sc[qt][1][2], sc[qt][1][3])));
            }
        }
        float t16[4];
#pragma unroll
        for (int qt = 0; qt < 4; ++qt) t16[qt] = __shfl_xor(mx[qt], 16);
#pragma unroll
        for (int qt = 0; qt < 4; ++qt) mx[qt] = fmaxf(mx[qt], t16[qt]);
#pragma unroll
        for (int qt = 0; qt < 4; ++qt) t16[qt] = __shfl_xor(mx[qt], 32);
        float alpha[4]; bool resc = false;
#pragma unroll
        for (int qt = 0; qt < 4; ++qt) {
            mx[qt] = fmaxf(mx[qt], t16[qt]);
            const float mn = fmaxf(mrun[qt], mx[qt]);
            alpha[qt] = __builtin_amdgcn_exp2f(mrun[qt] - mn);
            resc = resc || (mn != mrun[qt]);
            mrun[qt] = mn;
        }
        bf16x8 pb[4];
#pragma unroll
        for (int qt = 0; qt < 4; ++qt) {
            float pr[8];
#pragma unroll
            for (int r = 0; r < 4; ++r) { pr[r] = __builtin_amdgcn_exp2f(sc[qt][0][r] - mrun[qt]); pr[4 + r] = __builtin_amdgcn_exp2f(sc[qt][1][r] - mrun[qt]); }
            lrun[qt] = lrun[qt] * alpha[qt] + ((pr[0] + pr[1]) + (pr[2] + pr[3])) + ((pr[4] + pr[5]) + (pr[6] + pr[7]));
            u32x4 pw; pw.x = cvt_pk_bf16(pr[0], pr[1]); pw.y = cvt_pk_bf16(pr[2], pr[3]); pw.z = cvt_pk_bf16(pr[4], pr[5]); pw.w = cvt_pk_bf16(pr[6], pr[7]);
            pb[qt] = __builtin_bit_cast(bf16x8, pw);
        }
        if (__any(resc)) {
#pragma unroll
            for (int qt = 0; qt < 4; ++qt)
#pragma unroll
                for (int dt = 0; dt < 4; ++dt) o[qt][dt] *= alpha[qt];
        }
#pragma unroll
        for (int qt = 0; qt < 4; ++qt)
#pragma unroll
            for (int dt = 0; dt < 4; ++dt) o[qt][dt] = __builtin_amdgcn_mfma_f32_16x16x32_bf16(vf[dt], pb[qt], o[qt][dt], 0, 0, 0);
    }
#undef AT_ISSUE
    const float sink = p.attn_sink[head];
#pragma unroll
    for (int qt = 0; qt < 4; ++qt) {
        float lt = lrun[qt]; lt += __shfl_xor(lt, 16); lt += __shfl_xor(lt, 32);
        lt += __builtin_amdgcn_exp2f(sink * 1.44269504f - mrun[qt]);
        const float inv = 1.0f / lt;
        bf16_t* dst = oatt + (size_t)(b * T + q0 + qt * 16 + fr) * 512 + head * 64 + fq * 4;
#pragma unroll
        for (int dt = 0; dt < 4; ++dt) { const f32x4 v = o[qt][dt] * inv; u32x2 w; w.x = cvt_pk_bf16(v[0], v[1]); w.y = cvt_pk_bf16(v[2], v[3]);
            *(u32x2*)(dst + dt * 16) = w; }
    }
    asm volatile("s_waitcnt vmcnt(0)" ::: "memory");
}

constexpr int LQS = 0, LQT = 17408, LKT = 34816, LST = 52224, LKDT = 87040, LVT = 105472, LPP = 123904, LCUM = 133120, LDEC = 135168, LROPE = 131072, LXST = 139264;
__device__ __forceinline__ void hgrn_unit(const Params& p, int unit, LAS unsigned char* lds, int tid) {
    const int dir = unit & 1, h = (unit >> 1) & 3, b = unit >> 3;
    const int wid = tid >> 6, lane = tid & 63, fr = lane & 15, fq = lane >> 4;
    const bf16_t* hbuf = (const bf16_t*)(p.ws + OFF_HBUF);
    bf16_t* odir = (bf16_t*)(p.ws + OFF_ODIR) + (size_t)dir * MLAT * 512;
    LAS bf16_t* Lqs = (LAS bf16_t*)(lds + LQS); LAS bf16_t* Lqt = (LAS bf16_t*)(lds + LQT); LAS bf16_t* Lkt = (LAS bf16_t*)(lds + LKT);
    LAS bf16_t* Lst = (LAS bf16_t*)(lds + LST); LAS bf16_t* Lkdt = (LAS bf16_t*)(lds + LKDT); LAS bf16_t* Lvt = (LAS bf16_t*)(lds + LVT);
    LAS bf16_t* Lp = (LAS bf16_t*)(lds + LPP); LAS float* Lcum = (LAS float*)(lds + LCUM); LAS float* Ldec = (LAS float*)(lds + LDEC);
    const int d = tid & 127, tg = tid >> 7;
    const float* lbraw = dir ? p.lb_bwd : p.lb_fwd;
    const float lbv = 1.0f / (1.0f + __expf(lbraw[512 + h * 128 + d] - lbraw[h * 128 + d]));
    const int colF = (dir ? 1024 : 512) + h * 128 + d, colQ = h * 128 + d, colV = 1536 + h * 128 + d;
    f32x4 Sacc[8];
#pragma unroll
    for (int ei = 0; ei < 8; ++ei) Sacc[ei] = (f32x4){0.f, 0.f, 0.f, 0.f};
#define LDSBAR() do { asm volatile("s_waitcnt lgkmcnt(0)" ::: "memory"); __builtin_amdgcn_s_barrier(); asm volatile("" ::: "memory"); } while (0)
    bf16_t pz[16], pq[16], pv[16];
#define HG_LOAD(cn) do { const bool latn_ = (cn) >= 4; const int ccn_ = latn_ ? (cn) - 4 : (cn); const int rbn_ = latn_ ? b * T : MLAT + b * L; const int sln_ = latn_ ? T - 1 : L - 1; \
        _Pragma("unroll") for (int i = 0; i < 16; ++i) { const int tl_ = ccn_ * 64 + tg * 16 + i, tok_ = dir ? sln_ - tl_ : tl_; const bf16_t* rp_ = hbuf + (size_t)(rbn_ + tok_) * 2048; pz[i] = rp_[colF]; pv[i] = rp_[colV]; if (latn_) pq[i] = rp_[colQ]; } } while (0)
#pragma unroll
    for (int i = 0; i < 16; ++i) pq[i] = 0;
    HG_LOAD(0);
#pragma unroll
    for (int ei = 0; ei < 8; ++ei) { u32x2 z; z.x = 0u; z.y = 0u; *(LAS u32x2*)(Lst + (ei * 16 + fr) * 136 + wid * 16 + fq * 4) = z; }
    LDSBAR();
    for (int c = 0; c < 36; ++c) {
        const bool lat = c >= 4;
        const int cc = lat ? c - 4 : c;
        const int rowbase = lat ? b * T : MLAT + b * L;
        const int seglast = lat ? T - 1 : L - 1;
        float gp[16], kk[16];
#pragma unroll
        for (int i = 0; i < 16; ++i) {
            const float z = bf2f(pz[i]);
            const float f = lbv + (1.0f - lbv) * sigmoidf_(z);
            gp[i] = f; kk[i] = 1.0f - f;
        }
        { float run = gp[15];
#pragma unroll
          for (int i = 14; i >= 0; --i) { kk[i] *= run; run *= gp[i]; } }
#pragma unroll
        for (int i = 1; i < 16; ++i) gp[i] *= gp[i - 1];
        Lcum[tg * 128 + d] = __logf(gp[15]);
        LDSBAR();
        const float c0 = Lcum[d], c1 = Lcum[128 + d], c2 = Lcum[256 + d], c3 = Lcum[384 + d];
        const float off = tg == 0 ? 0.f : tg == 1 ? c0 : tg == 2 ? c0 + c1 : c0 + c1 + c2;
        const float mid = c0 + c1, tot = (c0 + c1) + (c2 + c3);
        const float e_off = __expf(off), e_om = __expf(off - mid), e_mo = __expf(mid - off), e_to = __expf(tot - off);
        const float rgl = __builtin_amdgcn_rcpf(gp[15]);
#define rg kk
#pragma unroll
        for (int i = 0; i < 16; ++i) kk[i] *= rgl;
        if (lat) {
#pragma unroll
            for (int i = 0; i < 16; ++i) {
                const int t = tg * 16 + i;
                const float qg = bf2f(pq[i]) * gp[i];
                Lqs[t * 136 + d] = f2bf(qg * e_off);
                Lqt[t * 136 + d] = f2bf(qg * e_om);
                Lkt[t * 136 + d] = f2bf(rg[i] * e_mo);
            }
        }
        {
            u32x4 w0, w1;
            w0.x = cvt_pk_bf16(rg[0] * e_to, rg[1] * e_to); w0.y = cvt_pk_bf16(rg[2] * e_to, rg[3] * e_to); w0.z = cvt_pk_bf16(rg[4] * e_to, rg[5] * e_to); w0.w = cvt_pk_bf16(rg[6] * e_to, rg[7] * e_to);
            w1.x = cvt_pk_bf16(rg[8] * e_to, rg[9] * e_to); w1.y = cvt_pk_bf16(rg[10] * e_to, rg[11] * e_to); w1.z = cvt_pk_bf16(rg[12] * e_to, rg[13] * e_to); w1.w = cvt_pk_bf16(rg[14] * e_to, rg[15] * e_to);
            *(LAS u32x4*)(Lkdt + d * 72 + tg * 16) = w0; *(LAS u32x4*)(Lkdt + d * 72 + tg * 16 + 8) = w1;
            if (tg == 0) Ldec[d] = __expf(tot);
        }
        {
            u32x4 w0, w1;
            w0.x = pv[0] | ((unsigned)pv[1] << 16); w0.y = pv[2] | ((unsigned)pv[3] << 16); w0.z = pv[4] | ((unsigned)pv[5] << 16); w0.w = pv[6] | ((unsigned)pv[7] << 16);
            w1.x = pv[8] | ((unsigned)pv[9] << 16); w1.y = pv[10] | ((unsigned)pv[11] << 16); w1.z = pv[12] | ((unsigned)pv[13] << 16); w1.w = pv[14] | ((unsigned)pv[15] << 16);
            *(LAS u32x4*)(Lvt + d * 72 + tg * 16) = w0; *(LAS u32x4*)(Lvt + d * 72 + tg * 16 + 8) = w1;
        }
        if (c + 1 < 36) HG_LOAD(c + 1);
        LDSBAR();
        if (lat) {
            const int ti = wid >> 1;
#pragma unroll
            for (int uu = 0; uu < 2; ++uu) {
                const int si = (wid & 1) * 2 + uu;
                f32x4 a = (f32x4){0.f, 0.f, 0.f, 0.f};
#pragma unroll
                for (int k4 = 0; k4 < 4; ++k4) {
                    const bf16x8 af = *(const LAS bf16x8*)(Lqt + (ti * 16 + fr) * 136 + k4 * 32 + fq * 8);
                    const bf16x8 bf = *(const LAS bf16x8*)(Lkt + (si * 16 + fr) * 136 + k4 * 32 + fq * 8);
                    a = __builtin_amdgcn_mfma_f32_16x16x32_bf16(af, bf, a, 0, 0, 0);
                }
                const int s = si * 16 + fr;
#pragma unroll
                for (int r = 0; r < 4; ++r) { const int t = ti * 16 + fq * 4 + r; const float v = (si <= ti && s <= t) ? a[r] : 0.f; Lp[t * 72 + s] = f2bf(v); }
            }
            LDSBAR();
#pragma unroll
            for (int uu = 0; uu < 4; ++uu) {
                const int ei = (wid & 1) * 4 + uu;
                f32x4 a = (f32x4){0.f, 0.f, 0.f, 0.f};
#pragma unroll
                for (int k4 = 0; k4 < 4; ++k4) {
                    const bf16x8 af = *(const LAS bf16x8*)(Lqs + (ti * 16 + fr) * 136 + k4 * 32 + fq * 8);
                    const bf16x8 bf = *(const LAS bf16x8*)(Lst + (ei * 16 + fr) * 136 + k4 * 32 + fq * 8);
                    a = __builtin_amdgcn_mfma_f32_16x16x32_bf16(af, bf, a, 0, 0, 0);
                }
#pragma unroll
                for (int k2 = 0; k2 < 2; ++k2) {
                    const bf16x8 af = *(const LAS bf16x8*)(Lp + (ti * 16 + fr) * 72 + k2 * 32 + fq * 8);
                    const bf16x8 bf = *(const LAS bf16x8*)(Lvt + (ei * 16 + fr) * 72 + k2 * 32 + fq * 8);
                    a = __builtin_amdgcn_mfma_f32_16x16x32_bf16(af, bf, a, 0, 0, 0);
                }
#pragma unroll
                for (int r = 0; r < 4; ++r) {
                    const int tl = cc * 64 + ti * 16 + fq * 4 + r, tok = dir ? seglast - tl : tl;
                    odir[(size_t)(rowbase + tok) * 512 + h * 128 + ei * 16 + fr] = f2bf(a[r]);
                }
            }
        }
        {
            const f32x4 dec = *(const LAS f32x4*)(Ldec + wid * 16 + fq * 4);
#pragma unroll
            for (int ei = 0; ei < 8; ++ei) {
                f32x4 a = Sacc[ei] * dec;
#pragma unroll
                for (int k2 = 0; k2 < 2; ++k2) {
                    const bf16x8 af = *(const LAS bf16x8*)(Lkdt + (wid * 16 + fr) * 72 + k2 * 32 + fq * 8);
                    const bf16x8 bf = *(const LAS bf16x8*)(Lvt + (ei * 16 + fr) * 72 + k2 * 32 + fq * 8);
                    a = __builtin_amdgcn_mfma_f32_16x16x32_bf16(af, bf, a, 0, 0, 0);
                }
                Sacc[ei] = a;
            }
        }
        LDSBAR();
#pragma unroll
        for (int ei = 0; ei < 8; ++ei) { u32x2 w; w.x = cvt_pk_bf16(Sacc[ei][0], Sacc[ei][1]); w.y = cvt_pk_bf16(Sacc[ei][2], Sacc[ei][3]);
            *(LAS u32x2*)(Lst + (ei * 16 + fr) * 136 + wid * 16 + fq * 4) = w; }
    }
    __syncthreads();
#undef HG_LOAD
#undef rg
}

#define XB_TMO      128
#define XB_XCNT(j)  (256  + 64 * (j))
#define XB_XSUB(j)  (1280 + 64 * (j))
#define XB_XGEN(j)  (2304 + 64 * (j))
#define XB_TOP      3328
#define XB_TOPGEN   3392
#define XCD_BAR_WORDS 3456
#define XB_SPIN_CAP (1u << 20)
__device__ __forceinline__ unsigned xb_ld(unsigned* p)              { return __hip_atomic_load(p, __ATOMIC_RELAXED, __HIP_MEMORY_SCOPE_AGENT); }
__device__ __forceinline__ unsigned xb_add(unsigned* p, unsigned v) { return __hip_atomic_fetch_add(p, v, __ATOMIC_RELAXED, __HIP_MEMORY_SCOPE_AGENT); }
__device__ __forceinline__ unsigned xb_xcc_id() { return (unsigned)__builtin_amdgcn_s_getreg((3 << 11) | 20) & 0xFu; }
#define XB_SPIN(cond, bar) do { unsigned _sp = 0; while (cond) { __builtin_amdgcn_s_sleep(1); \
    if ((++_sp & 255u) == 0u) { if (xb_ld(&(bar)[XB_TMO])) break; if (_sp > XB_SPIN_CAP) { atomicAdd(&(bar)[XB_TMO], 1u); break; } } } } while (0)
__device__ __forceinline__ void xcd_barrier_complete(unsigned* bar, unsigned x, unsigned& nloc, unsigned& nx) {
    const unsigned G = gridDim.x * gridDim.y * gridDim.z;
    unsigned sum, cnt, mine, sp = 0u;
    for (;;) {
        sum = 0u; cnt = 0u; mine = 0u;
#pragma unroll
        for (unsigned j = 0; j < 16; ++j) { const unsigned c = xb_ld(&bar[XB_XCNT(j)]); sum += c; cnt += (c > 0u) ? 1u : 0u; mine = (j == x) ? c : mine; }
        if (sum == G) break;
        __builtin_amdgcn_s_sleep(1);
        if ((++sp & 255u) == 0u) { if (xb_ld(&bar[XB_TMO])) break; if (sp > XB_SPIN_CAP) { atomicAdd(&bar[XB_TMO], 1u); break; } }
    }
    nloc = mine > 0u ? mine : 1u; nx = cnt > 0u ? cnt : 1u;
}
__device__ __forceinline__ void xcd_barrier(unsigned* bar, volatile LAS unsigned* st) {
    asm volatile("s_waitcnt vmcnt(0)" ::: "memory");
    __syncthreads();
    if (threadIdx.x == 0) {
        const unsigned x = xb_xcc_id();
        __builtin_amdgcn_s_waitcnt(0);
        unsigned nloc = st[0], nx = st[1];
        if (nloc == 0u) { xcd_barrier_complete(bar, x, nloc, nx); st[0] = nloc; st[1] = nx; }
        const unsigned old = xb_add(&bar[XB_XSUB(x)], 1u);
        const unsigned gen = old / nloc;
        if (old + 1u == (gen + 1u) * nloc) {
            __builtin_amdgcn_fence(__ATOMIC_RELEASE, "agent");
            asm volatile("s_waitcnt vmcnt(0)" ::: "memory");
            const unsigned og = xb_add(&bar[XB_TOP], 1u);
            const unsigned tg = og / nx;
            if (og + 1u == (tg + 1u) * nx) xb_add(&bar[XB_TOPGEN], 1u);
            else XB_SPIN(xb_ld(&bar[XB_TOPGEN]) == tg, bar);
            __builtin_amdgcn_fence(__ATOMIC_ACQUIRE, "agent");
            xb_add(&bar[XB_XGEN(x)], 1u);
            asm volatile("s_waitcnt vmcnt(0)" ::: "memory");
        } else {
            XB_SPIN(xb_ld(&bar[XB_XGEN(x)]) == gen, bar);
            __builtin_amdgcn_fence(__ATOMIC_ACQUIRE, "agent");
            asm volatile("s_waitcnt vmcnt(0)" ::: "memory");
        }
    }
    __syncthreads();
}

__global__ void __launch_bounds__(512, 2) mega(Params p, int ph_lo, int ph_hi) {
    extern __shared__ __attribute__((aligned(16))) unsigned char shm[];
    LAS unsigned char* lds = (LAS unsigned char*)shm;
    volatile LAS unsigned* xst = (volatile LAS unsigned*)(lds + LXST);
    unsigned* xbar = (unsigned*)(p.ws + OFF_BAR);
    if (threadIdx.x == 0) { xst[0] = 0u; xst[1] = 0u; }
    __syncthreads();
    if (ph_hi - ph_lo > 1 && threadIdx.x == 0) (void)xb_add(&xbar[XB_XCNT(xb_xcc_id())], 1u);
#ifndef PROBE_PH
#define PROBE_PH -1
#define PROBE_EXTRA 0
#endif
    for (int phi = ph_lo; phi < ph_hi + PROBE_EXTRA; ++phi) {
        const int ph = (PROBE_PH < 0 || phi <= PROBE_PH) ? phi : (phi <= PROBE_PH + PROBE_EXTRA ? PROBE_PH : phi - PROBE_EXTRA);
        int tid = threadIdx.x; asm volatile("" : "+v"(tid));
        int G = gridDim.x, c = blockIdx.x; asm volatile("" : "+s"(G), "+s"(c));
        unsigned char* ws = p.ws;
        const int wid = tid >> 6, lane = tid & 63;
        const float* mod = (const float*)(ws + OFF_MOD);
        switch (ph) {
        case 0: if (PH_ON(0)) {
            for (int it = c; it < 288 + 1; it += G) {
                if (it < 288) mod_partial_item(p, it, (LAS float*)lds, tid);
                else { for (int i = tid; i < 1024; i += 512) { const int pos = i >> 4, fi = i & 15; const float fr_ = powf(10000.0f, -(float)fi / 16.0f), ang = (float)pos * fr_;
                        ((float2*)(ws + OFF_ROPE))[i] = make_float2(cosf(ang), sinf(ang)); } }
            }
            __syncthreads();
            convert_tiles(p, ws, 0, 3968, c, G, (LAS float*)lds, tid);
        } break;
        case 1: if (PH_ON(1)) {
            const float* part = (const float*)(ws + OFF_PART);
            for (int i = c * 512 + tid; i < 17 * NMOD * D; i += G * 512) {
                const int n = i % (NMOD * D);
                float s = p.b_ada[n];
#pragma unroll
                for (int ks = 0; ks < 16; ++ks) s += part[(size_t)ks * 17 * NMOD * D + i];
                ((float*)(ws + OFF_MOD))[i] = s;
            }
        } break;
        case 2: if (PH_ON(2)) {
            const int gw = c * 8 + wid, rpw = MALL / (G * 8);
            rows_phase<false, true, false, 0>(mod, gw * rpw, gw * rpw + rpw, p.x, p.ctx, (const bf16_t*)p.out, (const bf16_t*)(ws + OFF_Y), 0.f, 0, p.norm_post, p.out, p.norm_pre, 0, (bf16_t*)(ws + OFF_HA), lane);
        } break;
        case 3: case 13: if (PH_ON(3)) {
            const bool second = ph == 13;
            RectOrder S; S.A = (const char*)(ws + OFF_HA); S.B = (const char*)(ws + OFF_WFFN_IN); S.K = D; S.nM = second ? 128 : 144; S.nN = 22; S.nwg = S.nM * S.nN; S.G = G; S.c = c; S.pm0 = 0;
            EpiSwiglu E; E.act = (bf16_t*)(ws + OFF_ACT);
            gemm_phase(lds, D, S, E, tid);
        } break;
        case 4: case 5: case 11: case 14: if (PH_ON(4)) {
            RectOrder S; S.G = G; S.c = c; S.nN = 4; S.pm0 = 0; int K; bool dogemm = true;
            if (ph == 11) { S.A = (const char*)(ws + OFF_U); S.B = (const char*)(ws + OFF_WOUT); K = D; S.nM = 128; }
            else { S.A = (const char*)(ws + OFF_ACT); S.B = (const char*)(ws + OFF_WFFN_OUT); K = DFF; S.nM = 128; }
            if (ph == 5) {
                if (c >= 64) {
                    dogemm = false;
                    const int nw = (G - 64) * 8, gw = (c - 64) * 8 + wid, rpw = (MLAT + nw - 1) / nw;
                    const int r0 = gw * rpw, r1 = r0 + rpw < MLAT ? r0 + rpw : MLAT;
                    if (r0 < MLAT) rows_phase<true, true, false, 1>(mod, r0, r1, p.x, p.ctx, (const bf16_t*)p.out, (const bf16_t*)(ws + OFF_Y), 0.5f, 2, p.norm_post, p.out, p.norm_pre + D, 3, (bf16_t*)(ws + OFF_HA), lane);
                } else { S.nM = 16; S.pm0 = 128; S.G = 64; }
            }
            S.K = K; S.nwg = S.nM * S.nN;
            if (dogemm) {
                EpiBf16 E; E.C = (bf16_t*)(ws + OFF_Y); E.ldc = D;
                gemm_phase(lds, K, S, E, tid);
            }
        } break;
        case 6: if (PH_ON(5)) {
            const int gw = c * 8 + wid, rpw = MCTX / (G * 8);
            rows_phase<true, true, false, 0>(mod, MLAT + gw * rpw, MLAT + gw * rpw + rpw, p.x, p.ctx, (const bf16_t*)p.out, (const bf16_t*)(ws + OFF_Y), 0.5f, 2, p.norm_post, p.out, p.norm_pre + D, 3, (bf16_t*)(ws + OFF_HA), lane);
        } break;
        case 7: if (PH_ON(6)) {
            MixOrder S; S.A = (const char*)(ws + OFF_HA); S.B = (const char*)(ws + OFF_WMIX); S.G = G; S.c = c;
            EpiMixIn E; E.qbuf = (bf16_t*)(ws + OFF_QBUF); E.kall = (bf16_t*)(ws + OFF_KALL); E.vt = (bf16_t*)(ws + OFF_VT); E.hbuf = (bf16_t*)(ws + OFF_HBUF); E.gbuf = (bf16_t*)(ws + OFF_GBUF);
            ((LAS f32x4*)(lds + 131072))[tid] = ((const f32x4*)(ws + OFF_ROPE))[tid];
            __syncthreads();
            E.rope = (const LAS float2*)(lds + 131072);
            gemm_phase(lds, D, S, E, tid);
        } break;
        case 8: if (PH_ON(7)) {
            const int half = G >> 1;
#ifndef REP_HGRN
#define REP_HGRN 1
#define REP_ATTN 1
#endif
            if (c < half) { for (int rep = 0; rep < REP_HGRN; ++rep) for (int it = c; it < 128; it += half) hgrn_unit(p, it, lds, tid);
                convert_tiles(p, ws, 1, 2112, c, half, (LAS float*)lds, tid); }
            else { int tid2 = tid; asm volatile("" : "+v"(tid2));
                for (int rep = 0; rep < REP_ATTN; ++rep) for (int it = c - half; it < 512; it += G - half) attn_item(p, it, tid2, lds);
            }
        } break;
        case 9: if (PH_ON(8)) {
            const bf16_t* of = (const bf16_t*)(ws + OFF_ODIR); const bf16_t* ob = of + (size_t)MLAT * 512;
            const bf16_t* gb = (const bf16_t*)(ws + OFF_GBUF); bf16_t* orr = (bf16_t*)(ws + OFF_OR);
            for (int r = c * 8 + wid; r < MLAT; r += G * 8) {
                const u32x4 a = *(const u32x4*)(of + (size_t)r * 512 + lane * 8), bq = *(const u32x4*)(ob + (size_t)r * 512 + lane * 8);
                const u32x4 gq = *(const u32x4*)(gb + (size_t)r * 2560 + lane * 8);
                float v[8]; float ss = 0.f;
#pragma unroll
                for (int q = 0; q < 4; ++q) { v[q * 2] = bflo(a[q]) + bflo(bq[q]); v[q * 2 + 1] = bfhi(a[q]) + bfhi(bq[q]); ss += v[q * 2] * v[q * 2] + v[q * 2 + 1] * v[q * 2 + 1]; }
                ss = wave_sum(ss);
                const float rstd = rsqrtf(ss * (1.0f / 512.0f) + EPS);
                const f32x4 g0 = *(const f32x4*)(p.hgrn_norm + lane * 8), g1 = *(const f32x4*)(p.hgrn_norm + lane * 8 + 4);
                float o[8];
#pragma unroll
                for (int q = 0; q < 4; ++q) {
                    const float h0 = bflo(gq[q]), h1 = bfhi(gq[q]);
                    const float gg0 = q < 2 ? g0[q * 2] : g1[q * 2 - 4], gg1 = q < 2 ? g0[q * 2 + 1] : g1[q * 2 - 3];
                    o[q * 2] = v[q * 2] * rstd * gg0 * siluf_(h0); o[q * 2 + 1] = v[q * 2 + 1] * rstd * gg1 * siluf_(h1);
                }
                u32x4 w; w.x = cvt_pk_bf16(o[0], o[1]); w.y = cvt_pk_bf16(o[2], o[3]); w.z = cvt_pk_bf16(o[4], o[5]); w.w = cvt_pk_bf16(o[6], o[7]);
                *(u32x4*)(orr + (size_t)r * 512 + lane * 8) = w;
            }
            __syncthreads();
        } break;
        case 10: if (PH_ON(9)) {
            MergeOrder S; S.A0 = (const char*)(ws + OFF_OATT); S.B0 = (const char*)(ws + OFF_WOA); S.A1 = (const char*)(ws + OFF_OR); S.B1 = (const char*)(ws + OFF_WOH); S.G = G; S.c = c;
            EpiMerge E; E.gbuf = (const bf16_t*)(ws + OFF_GBUF); E.U = (bf16_t*)(ws + OFF_U);
            gemm_phase(lds, 512, S, E, tid);
        } break;
        case 12: if (PH_ON(11)) {
            const int gw = c * 8 + wid, rpw = MLAT / (G * 8);
            rows_phase<true, true, true, 1>(mod, gw * rpw, gw * rpw + rpw, p.x, p.ctx, (const bf16_t*)p.out, (const bf16_t*)(ws + OFF_Y), 1.0f, 5, p.norm_post + D, ws + OFF_X2, p.norm_pre + 2 * D, 6, (bf16_t*)(ws + OFF_HA), lane);
        } break;
        case 15: if (PH_ON(14)) {
            const int gw = c * 8 + wid, rpw = MLAT / (G * 8);
            rows_phase<true, false, true, 2>(mod, gw * rpw, gw * rpw + rpw, p.x, p.ctx, (const bf16_t*)(ws + OFF_X2), (const bf16_t*)(ws + OFF_Y), 0.5f, 8, p.norm_post + 2 * D, p.out, p.norm_pre, 0, (bf16_t*)(ws + OFF_HA), lane);
        } break;
        default: break;
        }
        if (phi + 1 < ph_hi + PROBE_EXTRA) xcd_barrier(xbar, xst);
    }
}

extern "C" void kernel_launch(void* const* d_in, const int* in_sizes, int n_in, void* d_out, int out_size, void* d_ws, size_t ws_size, hipStream_t stream) {
    static int grid_blocks = 0;
    if (!grid_blocks) {
        hipFuncSetAttribute((const void*)mega, hipFuncAttributeMaxDynamicSharedMemorySize, LDS_BYTES);
        int dev = 0, cus = 0, per_cu = 0;
        hipGetDevice(&dev);
        hipDeviceGetAttribute(&cus, hipDeviceAttributeMultiprocessorCount, dev);
        hipOccupancyMaxActiveBlocksPerMultiprocessor(&per_cu, mega, 512, LDS_BYTES);
        if (per_cu < 1) per_cu = 1;
        if (per_cu > 1) per_cu = 1;
        grid_blocks = cus * per_cu;
        if (grid_blocks > 256) grid_blocks = 256;
    }
    Params p{};
    const float** pp = (const float**)&p;
    for (int i = 0; i < 20; ++i) pp[i] = (const float*)d_in[i];
    p.out = (float*)d_out; p.ws = (unsigned char*)d_ws;
    hipMemsetAsync((unsigned char*)d_ws + OFF_BAR, 0, XCD_BAR_WORDS * sizeof(unsigned), stream);
#if MULTI_LAUNCH
    for (int ph = 0; ph < NPH; ++ph) { hipLaunchKernelGGL(mega, dim3(grid_blocks), dim3(512), LDS_BYTES, stream, p, ph, ph + 1); }
#else
    hipLaunchKernelGGL(mega, dim3(grid_blocks), dim3(512), LDS_BYTES, stream, p, 0, NPH);
#endif
}
```

```cpp
#include <hip/hip_runtime.h>
#include <hip/hip_cooperative_groups.h>
#include <cstdio>
namespace cg = cooperative_groups;

#ifndef MULTI_LAUNCH
#define MULTI_LAUNCH 0
#endif

#ifndef PHASE_MASK
#define PHASE_MASK 0xffff
#endif
#define PH_ON(n) (((PHASE_MASK) >> (n)) & 1)
#define LAS __attribute__((address_space(3)))
typedef unsigned short bf16_t;
typedef short bf16x8 __attribute__((ext_vector_type(8)));
typedef float f32x4 __attribute__((ext_vector_type(4)));
typedef unsigned u32x4 __attribute__((ext_vector_type(4)));
typedef unsigned u32x2 __attribute__((ext_vector_type(2)));

constexpr int D = 1024, NB = 16, T = 2048, L = 256, MLAT = NB * T, MCTX = NB * L, MALL = MLAT + MCTX;
constexpr int DFF = 2816, INW = 5376, NMOD = 9;
constexpr float EPS = 1e-6f;
constexpr int NPH = 16;
constexpr int LDS_BYTES = 139264 + 16;

constexpr size_t MiB = 1u << 20;
constexpr size_t OFF_WFFN_IN = 0;
constexpr size_t OFF_WFFN_OUT = 11 * MiB;
constexpr size_t OFF_WMIX = 11 * MiB + 5632 * 1024;
constexpr size_t OFF_WOA = 27 * MiB;
constexpr size_t OFF_WOH = 28 * MiB;
constexpr size_t OFF_WOUT = 29 * MiB;
constexpr size_t OFF_MOD = 31 * MiB;
constexpr size_t OFF_ROPE = 31 * MiB + 640 * 1024;
constexpr size_t OFF_BAR = 32 * MiB;
constexpr size_t OFF_HA = 33 * MiB;
constexpr size_t OFF_ODIR = 33 * MiB;
constexpr size_t OFF_Y = 105 * MiB;
constexpr size_t OFF_QBUF = 105 * MiB;
constexpr size_t OFF_OR = 105 * MiB;
constexpr size_t OFF_KALL = 137 * MiB;
constexpr size_t OFF_VT = 146 * MiB;
constexpr size_t OFF_OATT = 155 * MiB;
constexpr size_t OFF_ACT = 177 * MiB;
constexpr size_t OFF_PART = 177 * MiB;
constexpr size_t OFF_HBUF = 187 * MiB;
constexpr size_t OFF_U = 187 * MiB;
constexpr size_t OFF_GBUF = 331 * MiB;
constexpr size_t OFF_X2 = 400 * MiB;

struct Params {
    const float *x, *c, *ctx, *c_ctx, *w_ada, *b_ada, *norm_pre, *norm_post, *ffn1_w_in, *ffn1_w_out, *ffn2_w_in, *ffn2_w_out,
        *mix_w_in, *attn_sink, *lb_fwd, *lb_bwd, *hgrn_norm, *w_o_attn, *w_o_hgrn, *w_out;
    float* out;
    unsigned char* ws;
};

typedef __bf16 bf16x2_t __attribute__((ext_vector_type(2)));
__device__ __forceinline__ unsigned cvt_pk_bf16(float lo, float hi) { bf16x2_t v; v[0] = (__bf16)lo; v[1] = (__bf16)hi; return __builtin_bit_cast(unsigned, v); }
__device__ __forceinline__ bf16_t f2bf(float f) { return __builtin_bit_cast(bf16_t, (__bf16)f); }
__device__ __forceinline__ float bf2f(bf16_t b) { return __uint_as_float(((unsigned)b) << 16); }
__device__ __forceinline__ float bflo(unsigned w) { return __uint_as_float(w << 16); }
__device__ __forceinline__ float bfhi(unsigned w) { return __uint_as_float(w & 0xffff0000u); }
__device__ __forceinline__ float sigmoidf_(float v) { return __builtin_amdgcn_rcpf(1.0f + __builtin_amdgcn_exp2f(v * -1.44269504f)); }
__device__ __forceinline__ float siluf_(float v) { return v * __builtin_amdgcn_rcpf(1.0f + __builtin_amdgcn_exp2f(v * -1.44269504f)); }
__device__ __forceinline__ float wave_sum(float v) {
#pragma unroll
    for (int o = 32; o >= 1; o >>= 1) v += __shfl_xor(v, o);
    return v;
}

constexpr int BM = 256, BK = 64, HALF = 128, HTB = HALF * BK * 2, NXCD = 8, WGM = 8;
__device__ __forceinline__ int lds_byte(int r, int c) { const int st = (r >> 4) * 2 + (c >> 5), rr = r & 15, cc = c & 31, ob = rr * 64 + cc * 2; return st * 1024 + (ob ^ (((ob >> 9) & 1) << 5)); }
__device__ __forceinline__ void stage_rc(int b, int& R, int& C) { const int st = b / 1024, sb = b % 1024, swz = sb ^ (((sb >> 9) & 1) << 5); R = (st >> 1) * 16 + swz / 64; C = (st & 1) * 32 + (swz % 64) / 2; }
__device__ __forceinline__ int perm32(int rho) { const int n = rho >> 4, i = rho & 15; return 8 * (i >> 2) + 4 * n + (i & 3); }

struct Unit { int pm, pn, part; };

__device__ __forceinline__ void rect_map(int Lidx, int nwg, int nM, int nN, int& pm, int& pn) {
    int wgid = Lidx;
    { const int q = nwg / NXCD, r = nwg % NXCD, xcd = wgid % NXCD, off = wgid / NXCD; wgid = (xcd < r ? xcd * (q + 1) : r * (q + 1) + (xcd - r) * q) + off; }
    const int nig = WGM * nN, gid = wgid / nig, fm = gid * WGM, gsz = (nM - fm) < WGM ? (nM - fm) : WGM;
    pm = fm + ((wgid % nig) % gsz); pn = (wgid % nig) / gsz;
}

struct RectOrder {
    const char *A, *B; int K, nM, nN, nwg, G, c, pm0;
    __device__ __forceinline__ bool next(int i, Unit& u) const {
        const int Lidx = i * G + c; if (Lidx >= nwg) return false;
        rect_map(Lidx, nwg, nM, nN, u.pm, u.pn); u.pm += pm0; u.part = 0; return true;
    }
    __device__ __forceinline__ const char* aptr(const Unit& u) const { return A + (size_t)u.pm * 512 * K; }
    __device__ __forceinline__ const char* bptr(const Unit& u) const { return B + (size_t)u.pn * 512 * K; }
};
struct MixOrder {
    const char *A, *B; int G, c;
    __device__ __forceinline__ bool next(int i, Unit& u) const {
        const int Lidx = i * G + c; if (Lidx >= 2800) return false;
        if (Lidx < 2688) rect_map(Lidx, 2688, 128, 21, u.pm, u.pn);
        else { const int j = Lidx - 2688, cs = j >> 4; u.pm = 128 + (j & 15); u.pn = cs == 0 ? 2 : 4 + cs; }
        u.part = 0; return true;
    }
    __device__ __forceinline__ const char* aptr(const Unit& u) const { return A + (size_t)u.pm * 512 * 1024; }
    __device__ __forceinline__ const char* bptr(const Unit& u) const { return B + (size_t)u.pn * 512 * 1024; }
};
struct MergeOrder {
    const char *A0, *B0, *A1, *B1; int G, c;
    __device__ __forceinline__ bool next(int i, Unit& u) const {
        const int Lidx = (i >> 1) * G + c; if (Lidx >= 512) return false;
        rect_map(Lidx, 512, 128, 4, u.pm, u.pn); u.part = i & 1; return true;
    }
    __device__ __forceinline__ const char* aptr(const Unit& u) const { return (u.part ? A1 : A0) + (size_t)u.pm * 512 * 512; }
    __device__ __forceinline__ const char* bptr(const Unit& u) const { return (u.part ? B1 : B0) + (size_t)u.pn * 512 * 512; }
};

typedef f32x4 Acc[2][2][4][2];

struct EpiSwiglu {
    static constexpr bool PERM = true;
    bf16_t* act;
    __device__ __forceinline__ bool operator()(Acc& acc, const Unit& u, int wr, int wc, int fr, int fq) const {
#pragma unroll
        for (int ai = 0; ai < 2; ++ai)
#pragma unroll
            for (int m = 0; m < 4; ++m) {
                const int r = u.pm * BM + ai * HALF + wr * 64 + m * 16 + fr;
                float v[8];
#pragma unroll
                for (int n = 0; n < 2; ++n)
#pragma unroll
                    for (int j = 0; j < 4; ++j) { const float g = acc[ai][0][m][n][j], up = acc[ai][1][m][n][j]; v[n * 4 + j] = (g * up) * __builtin_amdgcn_rcpf(1.0f + __builtin_amdgcn_exp2f(g * -1.44269504f)); }
                u32x4 w; w.x = cvt_pk_bf16(v[0], v[1]); w.y = cvt_pk_bf16(v[2], v[3]); w.z = cvt_pk_bf16(v[4], v[5]); w.w = cvt_pk_bf16(v[6], v[7]);
                *(u32x4*)(act + (size_t)r * DFF + u.pn * 128 + wc * 32 + fq * 8) = w;
            }
        return false;
    }
};
struct EpiBf16 {
    static constexpr bool PERM = true;
    bf16_t* C; int ldc;
    __device__ __forceinline__ bool operator()(Acc& acc, const Unit& u, int wr, int wc, int fr, int fq) const {
#pragma unroll
        for (int ai = 0; ai < 2; ++ai)
#pragma unroll
            for (int m = 0; m < 4; ++m) {
                const int r = u.pm * BM + ai * HALF + wr * 64 + m * 16 + fr;
#pragma unroll
                for (int bj = 0; bj < 2; ++bj) {
                    const f32x4 v0 = acc[ai][bj][m][0], v1 = acc[ai][bj][m][1];
                    u32x4 w; w.x = cvt_pk_bf16(v0[0], v0[1]); w.y = cvt_pk_bf16(v0[2], v0[3]); w.z = cvt_pk_bf16(v1[0], v1[1]); w.w = cvt_pk_bf16(v1[2], v1[3]);
                    *(u32x4*)(C + (size_t)r * ldc + u.pn * BM + bj * HALF + wc * 32 + fq * 8) = w;
                }
            }
        return false;
    }
};
struct EpiMerge {
    static constexpr bool PERM = true;
    const bf16_t* gbuf; bf16_t* U;
    __device__ __forceinline__ bool operator()(Acc& acc, const Unit& u, int wr, int wc, int fr, int fq) const {
        const bool first = u.part == 0;
        const int colb = u.pn * BM + wc * 32 + fq * 8;
        const int rowb = u.pm * BM + wr * 64 + fr;
        u32x4 ghc[2], gac[2], ghn[2], gan[2];
#define MG_LOAD(GH, GA, it) do { const int r_ = rowb + ((it) >> 2) * HALF + ((it) & 3) * 16; \
        _Pragma("unroll") for (int bj = 0; bj < 2; ++bj) { GH[bj] = *(const u32x4*)(gbuf + (size_t)r_ * 2560 + 1536 + colb + bj * HALF); \
            if (first) GA[bj] = *(const u32x4*)(gbuf + (size_t)r_ * 2560 + 512 + colb + bj * HALF); else GA[bj] = GH[bj]; } } while (0)
        MG_LOAD(ghc, gac, 0);
#pragma unroll
        for (int it = 0; it < 8; ++it) {
            const int ai = it >> 2, m = it & 3;
            if (it < 7) MG_LOAD(ghn, gan, it + 1);
            const int r = rowb + ai * HALF + m * 16;
#pragma unroll
            for (int bj = 0; bj < 2; ++bj) {
                if (first) {
#pragma unroll
                    for (int q = 0; q < 4; ++q) {
                        const float a0 = bflo(gac[bj][q]), a1 = bfhi(gac[bj][q]), h0 = bflo(ghc[bj][q]), h1 = bfhi(ghc[bj][q]);
                        const float r0 = (1.0f + __builtin_amdgcn_exp2f(h0 * -1.44269504f)) * __builtin_amdgcn_rcpf(1.0f + __builtin_amdgcn_exp2f(a0 * -1.44269504f));
                        const float r1 = (1.0f + __builtin_amdgcn_exp2f(h1 * -1.44269504f)) * __builtin_amdgcn_rcpf(1.0f + __builtin_amdgcn_exp2f(a1 * -1.44269504f));
                        acc[ai][bj][m][q >> 1][(q & 1) * 2] *= r0; acc[ai][bj][m][q >> 1][(q & 1) * 2 + 1] *= r1;
                    }
                } else {
                    float v[8];
#pragma unroll
                    for (int q = 0; q < 4; ++q) {
                        const float h0 = bflo(ghc[bj][q]), h1 = bfhi(ghc[bj][q]);
                        v[q * 2] = acc[ai][bj][m][q >> 1][(q & 1) * 2] * sigmoidf_(h0); v[q * 2 + 1] = acc[ai][bj][m][q >> 1][(q & 1) * 2 + 1] * sigmoidf_(h1);
                    }
                    u32x4 w; w.x = cvt_pk_bf16(v[0], v[1]); w.y = cvt_pk_bf16(v[2], v[3]); w.z = cvt_pk_bf16(v[4], v[5]); w.w = cvt_pk_bf16(v[6], v[7]);
                    *(u32x4*)(U + (size_t)r * D + colb + bj * HALF) = w;
                }
            }
#pragma unroll
            for (int bj = 0; bj < 2; ++bj) { ghc[bj] = ghn[bj]; gac[bj] = gan[bj]; }
        }
#undef MG_LOAD
        return first;
    }
};
struct EpiMixIn {
    static constexpr bool PERM = true;
    bf16_t *qbuf, *kall, *vt, *hbuf, *gbuf; const LAS float2* rope;
    __device__ __forceinline__ bool operator()(Acc& acc, const Unit& u, int wr, int wc, int fr, int fq) const {
        const int pn = u.pn;
        const int rowb = u.pm * BM + wr * 64 + fr;
        if (pn <= 2) {
            const bool lat = u.pm < 128;
#pragma unroll
            for (int ai = 0; ai < 2; ++ai) {
            float2 cs[4][4];
#pragma unroll
            for (int it = 0; it < 4; ++it) {
                const int r = rowb + ai * HALF + it * 16;
                const int t = r & (T - 1), pos = (wc & 1) ? (t & 63) : (t >> 6);
#pragma unroll
                for (int j = 0; j < 4; ++j) { const LAS float* rp_ = (const LAS float*)(rope + pos * 16 + fq * 4 + j); cs[it][j] = lat ? make_float2(rp_[0], rp_[1]) : make_float2(1.0f, 0.0f); }
            }
#pragma unroll
            for (int it = 0; it < 4; ++it) {
                const int m = it;
                const int r = rowb + ai * HALF + m * 16;
                if (pn < 2) {
#pragma unroll
                    for (int bj = 0; bj < 2; ++bj) {
                        const f32x4 x1 = acc[ai][bj][m][0], x2 = acc[ai][bj][m][1];
                        float o1[4], o2[4];
#pragma unroll
                        for (int j = 0; j < 4; ++j) { o1[j] = (x1[j] * cs[it][j].x - x2[j] * cs[it][j].y) * 0.18033688f; o2[j] = (x1[j] * cs[it][j].y + x2[j] * cs[it][j].x) * 0.18033688f; }
                        bf16_t* dst = qbuf + (size_t)r * 512 + pn * 256 + bj * 128 + wc * 32 + fq * 4;
                        u32x2 w0, w1; w0.x = cvt_pk_bf16(o1[0], o1[1]); w0.y = cvt_pk_bf16(o1[2], o1[3]); w1.x = cvt_pk_bf16(o2[0], o2[1]); w1.y = cvt_pk_bf16(o2[2], o2[3]);
                        *(u32x2*)dst = w0; *(u32x2*)(dst + 16) = w1;
                    }
                } else {
                    const int b = lat ? (r >> 11) : ((r - MLAT) >> 8);
                    const int tpos = lat ? (r & (T - 1)) : (T + ((r - MLAT) & (L - 1)));
                    const int kvh = wc >> 1;
                    f32x4 x1 = acc[ai][0][m][0], x2 = acc[ai][0][m][1];
#pragma unroll
                    for (int j = 0; j < 4; ++j) { const float a = x1[j], bb = x2[j]; x1[j] = a * cs[it][j].x - bb * cs[it][j].y; x2[j] = a * cs[it][j].y + bb * cs[it][j].x; }
                    bf16_t* kd = kall + ((size_t)(b * 2 + kvh) * 2304 + tpos) * 64 + (wc & 1) * 32 + fq * 4;
                    u32x2 w0, w1; w0.x = cvt_pk_bf16(x1[0], x1[1]); w0.y = cvt_pk_bf16(x1[2], x1[3]); w1.x = cvt_pk_bf16(x2[0], x2[1]); w1.y = cvt_pk_bf16(x2[2], x2[3]);
                    *(u32x2*)kd = w0; *(u32x2*)(kd + 16) = w1;
                    const f32x4 v1 = acc[ai][1][m][0], v2 = acc[ai][1][m][1];
                    bf16_t* vd = vt + ((size_t)(b * 2 + kvh) * 64 + (wc & 1) * 32 + fq * 8) * 2304 + tpos;
#pragma unroll
                    for (int j = 0; j < 4; ++j) { vd[(size_t)j * 2304] = f2bf(v1[j]); vd[(size_t)(j + 4) * 2304] = f2bf(v2[j]); }
                }
            }
            }
        } else if (pn <= 4) {
#pragma unroll
            for (int ai = 0; ai < 2; ++ai)
#pragma unroll
                for (int m = 0; m < 4; ++m) {
                    const int r = rowb + ai * HALF + m * 16;
                    bf16_t* dst = hbuf + (size_t)r * 2048 + (pn - 3) * 256;
#pragma unroll
                    for (int bj = 0; bj < 2; ++bj) {
                        const f32x4 v0 = acc[ai][bj][m][0], v1 = acc[ai][bj][m][1];
                        u32x4 w; w.x = cvt_pk_bf16(siluf_(v0[0]), siluf_(v0[1])); w.y = cvt_pk_bf16(siluf_(v0[2]), siluf_(v0[3]));
                        w.z = cvt_pk_bf16(siluf_(v1[0]), siluf_(v1[1])); w.w = cvt_pk_bf16(siluf_(v1[2]), siluf_(v1[3]));
                        *(u32x4*)(dst + bj * 128 + wc * 32 + fq * 8) = w;
                    }
                }
        } else {
#pragma unroll
            for (int ai = 0; ai < 2; ++ai)
#pragma unroll
                for (int m = 0; m < 4; ++m) {
                    const int r = rowb + ai * HALF + m * 16;
                    bf16_t* dst = pn < 11 ? hbuf + (size_t)r * 2048 + (pn - 3) * 256 : gbuf + (size_t)r * 2560 + (pn - 11) * 256;
#pragma unroll
                    for (int bj = 0; bj < 2; ++bj) {
                        const f32x4 v0 = acc[ai][bj][m][0], v1 = acc[ai][bj][m][1];
                        u32x4 w; w.x = cvt_pk_bf16(v0[0], v0[1]); w.y = cvt_pk_bf16(v0[2], v0[3]); w.z = cvt_pk_bf16(v1[0], v1[1]); w.w = cvt_pk_bf16(v1[2], v1[3]);
                        *(u32x4*)(dst + bj * 128 + wc * 32 + fq * 8) = w;
                    }
                }
        }
        return false;
    }
};

template <class Epi, class Sched>
__device__ __forceinline__ void gemm_phase(LAS unsigned char* lds, const int K, const Sched& S, const Epi& E, const int tid) {
    const int wid = __builtin_amdgcn_readfirstlane(tid >> 6), lane = tid & 63, wr = wid >> 2, wc = wid & 3, fr = lane & 15, fq = lane >> 4;
    const int nt = K / BK;
    unsigned voffA[2], voffB[2];
#pragma unroll
    for (int i = 0; i < 2; ++i) { int R, C; stage_rc(tid * 16 + i * 8192, R, C); const int Rb = Epi::PERM ? ((R & ~31) + perm32(R & 31)) : R;
        voffA[i] = (unsigned)(R * K + C) * 2u; voffB[i] = (unsigned)(Rb * K + C) * 2u; }
    const size_t kstep = (size_t)(BK * 2);
    const size_t hstep = (size_t)HALF * K * 2;
    const unsigned ldsw = (unsigned)wid * 1024u;
    const int aoff = lds_byte(wr * 64 + fr, fq * 8), boff = lds_byte(wc * 32 + fr, fq * 8);
#define PG8_SA(b, h) (((b) * 2 + (h)) * HTB)
#define PG8_SB(b, h) ((4 + (b) * 2 + (h)) * HTB)
#define PG8_STAGE(bufoff, gbase, voff) do { _Pragma("unroll") for (int _i = 0; _i < 2; ++_i) \
        __builtin_amdgcn_global_load_lds((const unsigned*)((const char*)(gbase) + (voff)[_i]), (LAS unsigned*)(lds + (bufoff) + ldsw + _i * 8192), 16, 0, 0); } while (0)
#define PG8_LDA(dst, b, h) do { _Pragma("unroll") for (int m = 0; m < 4; ++m) _Pragma("unroll") for (int k = 0; k < 2; ++k) dst[m][k] = *(const LAS bf16x8*)(lds + PG8_SA(b, h) + aoff + m * 2048 + k * 1024); } while (0)
#define PG8_LDB(dst, b, h) do { _Pragma("unroll") for (int n = 0; n < 2; ++n) _Pragma("unroll") for (int k = 0; k < 2; ++k) dst[n][k] = *(const LAS bf16x8*)(lds + PG8_SB(b, h) + boff + n * 2048 + k * 1024); } while (0)
#define PG8_MMA(ai, bj, At, Bt) do { __builtin_amdgcn_s_setprio(1); _Pragma("unroll") for (int m = 0; m < 4; ++m) _Pragma("unroll") for (int n = 0; n < 2; ++n) _Pragma("unroll") for (int k = 0; k < 2; ++k) \
        acc[ai][bj][m][n] = __builtin_amdgcn_mfma_f32_16x16x32_bf16(Bt[n][k], At[m][k], acc[ai][bj][m][n], 0, 0, 0); __builtin_amdgcn_s_setprio(0); } while (0)
#define PG8_WAIT_V(n) asm volatile("s_waitcnt vmcnt(" #n ")" ::: "memory")
#define PG8_WAIT_L(n) asm volatile("s_waitcnt lgkmcnt(" #n ")" ::: "memory")
#define PG8_BAR __builtin_amdgcn_s_barrier()
#define PG8_SCHED __builtin_amdgcn_sched_barrier(0)
    Unit cur, nxt; int ui = 0;
    if (!S.next(0, cur)) return;
    Acc acc;
#pragma unroll
    for (int a = 0; a < 2; ++a)
#pragma unroll
        for (int b = 0; b < 2; ++b)
#pragma unroll
            for (int m = 0; m < 4; ++m)
#pragma unroll
                for (int n = 0; n < 2; ++n) acc[a][b][m][n] = (f32x4){0.f, 0.f, 0.f, 0.f};
    bf16x8 At[4][2], B0[2][2], B1[2][2];
    const char* cA = S.aptr(cur); const char* cB = S.bptr(cur);
    PG8_STAGE(PG8_SB(0, 0), cB, voffB); PG8_STAGE(PG8_SA(0, 0), cA, voffA); PG8_STAGE(PG8_SB(0, 1), cB + hstep, voffB); PG8_STAGE(PG8_SA(0, 1), cA + hstep, voffA);
    if (wr == 1) PG8_BAR;
    PG8_WAIT_V(4); PG8_BAR;
    PG8_STAGE(PG8_SB(1, 0), cB + kstep, voffB); PG8_STAGE(PG8_SA(1, 0), cA + kstep, voffA); PG8_STAGE(PG8_SB(1, 1), cB + hstep + kstep, voffB);
    PG8_WAIT_V(6); PG8_BAR;
    for (;;) {
        const bool has_next = S.next(ui + 1, nxt);
        const char* nA = has_next ? S.aptr(nxt) : cA; const char* nB = has_next ? S.bptr(nxt) : cB;
        for (int t = 0; t < nt; t += 2) {
            const bool last = (t == nt - 2);
            const char* a1 = cA + (size_t)(t + 1) * kstep;
            const char* a2 = last ? nA : cA + (size_t)(t + 2) * kstep; const char* b2 = last ? nB : cB + (size_t)(t + 2) * kstep;
            const char* a3 = a2 + kstep; const char* b3 = b2 + kstep;
            PG8_LDB(B0, 0, 0); PG8_SCHED; PG8_LDA(At, 0, 0); PG8_STAGE(PG8_SA(1, 1), a1 + hstep, voffA);
            PG8_WAIT_L(8); PG8_BAR; PG8_WAIT_L(0); PG8_MMA(0, 0, At, B0); PG8_BAR; PG8_SCHED;
            PG8_LDB(B1, 0, 1); PG8_STAGE(PG8_SB(0, 0), b2, voffB);
            PG8_BAR; PG8_WAIT_L(0); PG8_MMA(0, 1, At, B1); PG8_BAR;
            PG8_LDA(At, 0, 1); PG8_STAGE(PG8_SA(0, 0), a2, voffA);
            PG8_BAR; PG8_WAIT_L(0); PG8_MMA(1, 0, At, B0); PG8_BAR; PG8_SCHED;
            PG8_STAGE(PG8_SB(0, 1), b2 + hstep, voffB);
            PG8_WAIT_V(6); PG8_BAR; PG8_MMA(1, 1, At, B1); PG8_BAR;
            PG8_LDB(B0, 1, 0); PG8_SCHED; PG8_LDA(At, 1, 0); PG8_STAGE(PG8_SA(0, 1), a2 + hstep, voffA);
            PG8_WAIT_L(8); PG8_BAR; PG8_WAIT_L(0); PG8_MMA(0, 0, At, B0); PG8_BAR; PG8_SCHED;
            PG8_LDB(B1, 1, 1); PG8_STAGE(PG8_SB(1, 0), b3, voffB);
            PG8_BAR; PG8_WAIT_L(0); PG8_MMA(0, 1, At, B1); PG8_BAR;
            PG8_LDA(At, 1, 1); PG8_STAGE(PG8_SA(1, 0), a3, voffA);
            PG8_BAR; PG8_WAIT_L(0); PG8_MMA(1, 0, At, B0); PG8_BAR; PG8_SCHED;
            PG8_STAGE(PG8_SB(1, 1), b3 + hstep, voffB);
            PG8_WAIT_V(6); PG8_BAR; PG8_MMA(1, 1, At, B1); PG8_BAR;
        }
        const bool keep = E(acc, cur, wr, wc, fr, fq);
        if (!has_next) break;
        if (!keep) {
#pragma unroll
            for (int a = 0; a < 2; ++a)
#pragma unroll
                for (int b = 0; b < 2; ++b)
#pragma unroll
                    for (int m = 0; m < 4; ++m)
#pragma unroll
                        for (int n = 0; n < 2; ++n) acc[a][b][m][n] = (f32x4){0.f, 0.f, 0.f, 0.f};
        }
        cur = nxt; cA = nA; cB = nB; ++ui;
    }
    PG8_WAIT_V(0);
    if (wr == 0) PG8_BAR;
    PG8_BAR;
#undef PG8_SA
#undef PG8_SB
#undef PG8_STAGE
#undef PG8_LDA
#undef PG8_LDB
#undef PG8_MMA
#undef PG8_WAIT_V
#undef PG8_WAIT_L
#undef PG8_BAR
#undef PG8_SCHED
}

struct TileDesc { const float* W; bf16_t* Bt; int K, N, mapmode, tile; };
__device__ __forceinline__ TileDesc tile_desc(const Params& p, unsigned char* ws, int t, int set) {
    TileDesc d;
    if (set == 0) {
        if (t < 1408) { d.W = p.ffn1_w_in; d.Bt = (bf16_t*)(ws + OFF_WFFN_IN); d.K = D; d.N = 2 * DFF; d.mapmode = 1; d.tile = t; }
        else if ((t -= 1408) < 704) { d.W = p.ffn1_w_out; d.Bt = (bf16_t*)(ws + OFF_WFFN_OUT); d.K = DFF; d.N = D; d.mapmode = 0; d.tile = t; }
        else if ((t -= 704) < 1344) { d.W = p.mix_w_in; d.Bt = (bf16_t*)(ws + OFF_WMIX); d.K = D; d.N = INW; d.mapmode = 2; d.tile = t; }
        else if ((t -= 1344) < 128) { d.W = p.w_o_attn; d.Bt = (bf16_t*)(ws + OFF_WOA); d.K = 512; d.N = D; d.mapmode = 0; d.tile = t; }
        else if ((t -= 128) < 128) { d.W = p.w_o_hgrn; d.Bt = (bf16_t*)(ws + OFF_WOH); d.K = 512; d.N = D; d.mapmode = 0; d.tile = t; }
        else { t -= 128; d.W = p.w_out; d.Bt = (bf16_t*)(ws + OFF_WOUT); d.K = D; d.N = D; d.mapmode = 0; d.tile = t; }
    } else {
        if (t < 1408) { d.W = p.ffn2_w_in; d.Bt = (bf16_t*)(ws + OFF_WFFN_IN); d.K = D; d.N = 2 * DFF; d.mapmode = 1; d.tile = t; }
        else { d.W = p.ffn2_w_out; d.Bt = (bf16_t*)(ws + OFF_WFFN_OUT); d.K = DFF; d.N = D; d.mapmode = 0; d.tile = t - 1408; }
    }
    return d;
}
__device__ __forceinline__ void convert_tiles(const Params& p, unsigned char* ws, int set, int ntiles, int first, int stride, LAS float* tl, int tid) {
    if (first >= ntiles) return;
    const int kk = tid >> 4, n4 = (tid & 15) * 4;
#define TILE_LOAD(dsc, A0, A1) do { const int ntn_ = (dsc).N >> 6, tk_ = (dsc).tile / ntn_, tn_ = (dsc).tile - tk_ * ntn_; \
        const float* src_ = (dsc).W + (size_t)(tk_ * 64 + kk) * (dsc).N + tn_ * 64 + n4; A0 = *(const f32x4*)src_; A1 = *(const f32x4*)(src_ + (size_t)32 * (dsc).N); } while (0)
#define CV_BAR() do { asm volatile("s_waitcnt lgkmcnt(0)" ::: "memory"); __builtin_amdgcn_s_barrier(); asm volatile("" ::: "memory"); } while (0)
    TileDesc cur = tile_desc(p, ws, first, set); f32x4 v0, v1; TILE_LOAD(cur, v0, v1);
    for (int t = first; t < ntiles; t += stride) {
        TileDesc nxt = cur; f32x4 n0 = v0, n1 = v1;
        if (t + stride < ntiles) { nxt = tile_desc(p, ws, t + stride, set); TILE_LOAD(nxt, n0, n1); }
#pragma unroll
        for (int j = 0; j < 4; ++j) { tl[kk * 65 + n4 + j] = v0[j]; tl[(kk + 32) * 65 + n4 + j] = v1[j]; }
        CV_BAR();
        {
            const int ntn = cur.N >> 6, tk = cur.tile / ntn, tn = cur.tile - tk * ntn, k0 = tk * 64, n0c = tn * 64;
            const int n = tid >> 3, ks = tid & 7; float v[8];
#pragma unroll
            for (int j = 0; j < 8; ++j) v[j] = tl[(ks * 8 + j) * 65 + n];
            int col = n0c + n, row = col;
            if (cur.mapmode == 1) { const int bj = col >= DFF ? 1 : 0, rem = col - bj * DFF; row = (rem >> 7) * 256 + bj * 128 + (rem & 127); }
            if (cur.mapmode == 2 && col < 640) { const int i32 = col & 31; row = (col & ~31) + 8 * ((i32 >> 2) & 3) + 4 * (i32 >> 4) + (i32 & 3); }
            u32x4 w; w.x = cvt_pk_bf16(v[0], v[1]); w.y = cvt_pk_bf16(v[2], v[3]); w.z = cvt_pk_bf16(v[4], v[5]); w.w = cvt_pk_bf16(v[6], v[7]);
            *(u32x4*)(cur.Bt + (size_t)row * cur.K + k0 + ks * 8) = w;
        }
        CV_BAR();
        cur = nxt; v0 = n0; v1 = n1;
    }
    __syncthreads();
#undef TILE_LOAD
#undef CV_BAR
}

__device__ __forceinline__ void mod_partial_item(const Params& p, int item, LAS float* sl, int tid) {
    const int ks = item / 18, chunk = item - ks * 18, col = chunk * 512 + tid;
    for (int i = tid; i < 17 * 64; i += 512) { const int b = i >> 6, kk = i & 63; const float cv = b < 16 ? p.c[b * D + ks * 64 + kk] : p.c_ctx[ks * 64 + kk]; sl[i] = siluf_(cv); }
    __syncthreads();
    float acc[17];
#pragma unroll
    for (int b = 0; b < 17; ++b) acc[b] = 0.f;
    const float* w = p.w_ada + (size_t)(ks * 64) * (NMOD * D) + col;
    for (int k0 = 0; k0 < 64; k0 += 16) {
        float wv[16];
#pragma unroll
        for (int j = 0; j < 16; ++j) wv[j] = w[(size_t)(k0 + j) * (NMOD * D)];
#pragma unroll
        for (int j = 0; j < 16; ++j)
#pragma unroll
            for (int b = 0; b < 17; ++b) acc[b] += sl[b * 64 + k0 + j] * wv[j];
    }
    float* part = (float*)(p.ws + OFF_PART);
#pragma unroll
    for (int b = 0; b < 17; ++b) part[(size_t)(ks * 17 + b) * (NMOD * D) + col] = acc[b];
    __syncthreads();
}

__device__ __forceinline__ void row_op(const float* src, const bf16_t* y, float w, const float* gate, const float* gpost, float* xdst,
                                       const float* gpre, const float* shift, const float* scale, bf16_t* hdst, int lane) {
    f32x4 v[4];
#pragma unroll
    for (int i = 0; i < 4; ++i) v[i] = *(const f32x4*)(src + i * 256 + lane * 4);
    if (y) {
        f32x4 yv[4]; float ss = 0.f;
#pragma unroll
        for (int i = 0; i < 4; ++i) { const u32x2 raw = *(const u32x2*)(y + i * 256 + lane * 4); yv[i] = (f32x4){bflo(raw.x), bfhi(raw.x), bflo(raw.y), bfhi(raw.y)};
            ss += yv[i][0] * yv[i][0] + yv[i][1] * yv[i][1] + yv[i][2] * yv[i][2] + yv[i][3] * yv[i][3]; }
        ss = wave_sum(ss);
        const float rstd = rsqrtf(ss * (1.0f / D) + EPS);
#pragma unroll
        for (int i = 0; i < 4; ++i) { const f32x4 g = *(const f32x4*)(gate + i * 256 + lane * 4), gp = *(const f32x4*)(gpost + i * 256 + lane * 4);
            v[i] = v[i] + (w * g) * ((yv[i] * rstd) * gp); }
        if (xdst) {
#pragma unroll
            for (int i = 0; i < 4; ++i) *(f32x4*)(xdst + i * 256 + lane * 4) = v[i];
        }
    }
    if (hdst) {
        float ss = 0.f;
#pragma unroll
        for (int i = 0; i < 4; ++i) ss += v[i][0] * v[i][0] + v[i][1] * v[i][1] + v[i][2] * v[i][2] + v[i][3] * v[i][3];
        ss = wave_sum(ss);
        const float rstd = rsqrtf(ss * (1.0f / D) + EPS);
#pragma unroll
        for (int i = 0; i < 4; ++i) { const f32x4 g = *(const f32x4*)(gpre + i * 256 + lane * 4), sh = *(const f32x4*)(shift + i * 256 + lane * 4), sc = *(const f32x4*)(scale + i * 256 + lane * 4);
            const f32x4 h = ((v[i] * rstd) * g) * (1.0f + sc) + sh;
            u32x2 o; o.x = cvt_pk_bf16(h[0], h[1]); o.y = cvt_pk_bf16(h[2], h[3]);
            *(u32x2*)(hdst + i * 256 + lane * 4) = o; }
    }
}

template <bool HASY, bool HASH, bool SRCBF, int XMODE>
__device__ __forceinline__ void rows_phase(const float* mod, int r0, int r1, const float* srcLat, const float* srcCtx, const bf16_t* srcB, const bf16_t* ybuf, float w, int gate_j,
                                           const float* gpost, void* xdst, const float* gpre, int shift_j, bf16_t* hdst, int lane) {
    f32x4 PA[4], PB[4], PC[4];
    f32x4 cv[4], nv[4]; u32x2 cy[4], ny[4];
    int curb = -1;
#define ROW_LOAD(V, Y, r) do { \
        if (SRCBF) { _Pragma("unroll") for (int i = 0; i < 4; ++i) { const u32x2 raw_ = *(const u32x2*)(srcB + (size_t)(r) * D + i * 256 + lane * 4); V[i] = (f32x4){bflo(raw_.x), bfhi(raw_.x), bflo(raw_.y), bfhi(raw_.y)}; } } \
        else { const float* sp_ = (r) < MLAT ? srcLat + (size_t)(r) * D : srcCtx + (size_t)((r) - MLAT) * D; \
            _Pragma("unroll") for (int i = 0; i < 4; ++i) V[i] = *(const f32x4*)(sp_ + i * 256 + lane * 4); } \
        if (HASY) { _Pragma("unroll") for (int i = 0; i < 4; ++i) Y[i] = *(const u32x2*)(ybuf + (size_t)(r) * D + i * 256 + lane * 4); } } while (0)
    ROW_LOAD(cv, cy, r0);
    f32x4 sxf[4]; u32x2 sxb[4], shb[4]; int rs = -1;
#define ROW_STORE() do { if (rs >= 0) { \
        if (HASY && XMODE == 2) { _Pragma("unroll") for (int i = 0; i < 4; ++i) *(f32x4*)((float*)xdst + (size_t)rs * D + i * 256 + lane * 4) = sxf[i]; } \
        if (HASY && XMODE == 1 && rs < MLAT) { _Pragma("unroll") for (int i = 0; i < 4; ++i) *(u32x2*)((bf16_t*)xdst + (size_t)rs * D + i * 256 + lane * 4) = sxb[i]; } \
        if (HASH) { _Pragma("unroll") for (int i = 0; i < 4; ++i) *(u32x2*)(hdst + (size_t)rs * D + i * 256 + lane * 4) = shb[i]; } } } while (0)
    for (int r = r0; r < r1; ++r) {
        ROW_STORE();
        if (r + 1 < r1) ROW_LOAD(nv, ny, r + 1);
        const int bb = r < MLAT ? (r >> 11) : 16;
        if (bb != curb) {
            curb = bb;
            const float* mr = mod + (size_t)bb * NMOD * D;
#pragma unroll
            for (int i = 0; i < 4; ++i) {
                const int cix = i * 256 + lane * 4;
                if (HASY) PA[i] = (*(const f32x4*)(mr + gate_j * D + cix) * w) * *(const f32x4*)(gpost + cix);
                if (HASH) { PB[i] = *(const f32x4*)(gpre + cix) * (1.0f + *(const f32x4*)(mr + (shift_j + 1) * D + cix)); PC[i] = *(const f32x4*)(mr + shift_j * D + cix); }
            }
        }
        if (HASY) {
            f32x4 yv[4]; float ss = 0.f;
#pragma unroll
            for (int i = 0; i < 4; ++i) { yv[i] = (f32x4){bflo(cy[i].x), bfhi(cy[i].x), bflo(cy[i].y), bfhi(cy[i].y)};
                ss += yv[i][0] * yv[i][0] + yv[i][1] * yv[i][1] + yv[i][2] * yv[i][2] + yv[i][3] * yv[i][3]; }
            ss = wave_sum(ss);
            const float rstd = rsqrtf(ss * (1.0f / D) + EPS);
#pragma unroll
            for (int i = 0; i < 4; ++i) cv[i] = cv[i] + PA[i] * (yv[i] * rstd);
            if (XMODE == 2) {
#pragma unroll
                for (int i = 0; i < 4; ++i) sxf[i] = cv[i];
            }
            if (XMODE == 1) {
#pragma unroll
                for (int i = 0; i < 4; ++i) { u32x2 o; o.x = cvt_pk_bf16(cv[i][0], cv[i][1]); o.y = cvt_pk_bf16(cv[i][2], cv[i][3]); sxb[i] = o;
                    if (r < MLAT) cv[i] = (f32x4){bflo(o.x), bfhi(o.x), bflo(o.y), bfhi(o.y)}; }
            }
        }
        if (HASH) {
            float ss = 0.f;
#pragma unroll
            for (int i = 0; i < 4; ++i) ss += cv[i][0] * cv[i][0] + cv[i][1] * cv[i][1] + cv[i][2] * cv[i][2] + cv[i][3] * cv[i][3];
            ss = wave_sum(ss);
            const float rstd = rsqrtf(ss * (1.0f / D) + EPS);
#pragma unroll
            for (int i = 0; i < 4; ++i) { const f32x4 h = (cv[i] * rstd) * PB[i] + PC[i];
                u32x2 o; o.x = cvt_pk_bf16(h[0], h[1]); o.y = cvt_pk_bf16(h[2], h[3]); shb[i] = o; }
        }
        rs = r;
#pragma unroll
        for (int i = 0; i < 4; ++i) { cv[i] = nv[i]; cy[i] = ny[i]; }
    }
    ROW_STORE();
#undef ROW_STORE
#undef ROW_LOAD
}

constexpr int AT_NS = 4, AT_STAGE = 8192;
__device__ __forceinline__ void attn_item(const Params& p, int item, int tid, LAS unsigned char* lds) {
    const bf16_t* qbuf = (const bf16_t*)(p.ws + OFF_QBUF);
    const bf16_t* kall = (const bf16_t*)(p.ws + OFF_KALL);
    const bf16_t* vtall = (const bf16_t*)(p.ws + OFF_VT);
    bf16_t* oatt = (bf16_t*)(p.ws + OFF_OATT);
    const int wid = __builtin_amdgcn_readfirstlane(tid >> 6), lane = tid & 63;
    const int qb = item & 15, kvh = (item >> 4) & 1, b = item >> 5;
    const int g = wid >> 1, qh = wid & 1, head = kvh * 4 + g, q0 = qb * 128 + qh * 64;
    const int fr = lane & 15, fq = lane >> 4;
    const bf16_t* Kp = kall + (size_t)(b * 2 + kvh) * 2304 * 64;
    const bf16_t* Vp = vtall + (size_t)(b * 2 + kvh) * 64 * 2304;
    const int blo = qb * 128 - 128 < 0 ? 0 : qb * 128 - 128, bhi = qb * 128 + 256 > T ? T : qb * 128 + 256;
    const int nbb = (bhi - blo) >> 5, ntile = nbb + 8;
    const int wlo = q0 - 128 < 0 ? 0 : q0 - 128, whi = q0 + 192 > T ? T : q0 + 192;
    const char* src; int tile_step;
    if (wid < 4) { const int key = tid >> 3, pc = tid & 7, ch = pc ^ (key & 7); src = (const char*)(Kp + (size_t)key * 64 + ch * 8); tile_step = 32 * 64 * 2; }
    else { const int j = tid - 256, row = j >> 2, pc = j & 3, ch = pc ^ ((row >> 2) & 3); src = (const char*)(Vp + (size_t)row * 2304 + ch * 8); tile_step = 32 * 2; }
    const unsigned ldsw = (unsigned)wid * 1024u;
#define AT_ISSUE(t) do { const int tt_ = (t) < ntile ? (t) : ntile - 1; const int k0_ = tt_ < nbb ? blo + tt_ * 32 : T + (tt_ - nbb) * 32; \
        __builtin_amdgcn_global_load_lds((const unsigned*)(src + (size_t)(k0_ >> 5) * tile_step), (LAS unsigned*)(lds + ((t) & (AT_NS - 1)) * AT_STAGE + ldsw), 16, 0, 0); } while (0)
    asm volatile("s_waitcnt lgkmcnt(0)" ::: "memory"); __builtin_amdgcn_s_barrier(); asm volatile("" ::: "memory");
    AT_ISSUE(0); AT_ISSUE(1); AT_ISSUE(2);
    bf16x8 qf[4][2];
#pragma unroll
    for (int qt = 0; qt < 4; ++qt)
#pragma unroll
        for (int kk = 0; kk < 2; ++kk) qf[qt][kk] = *(const bf16x8*)(qbuf + (size_t)(b * T + q0 + qt * 16 + fr) * 512 + head * 64 + kk * 32 + fq * 8);
    f32x4 o[4][4]; float mrun[4], lrun[4];
#pragma unroll
    for (int qt = 0; qt < 4; ++qt) { mrun[qt] = -1e30f; lrun[qt] = 0.f;
#pragma unroll
        for (int dt = 0; dt < 4; ++dt) o[qt][dt] = (f32x4){0.f, 0.f, 0.f, 0.f}; }
    asm volatile("s_waitcnt vmcnt(0)" ::: "memory");
    for (int it = 0; it < ntile; ++it) {
        if (it > 0) asm volatile("s_waitcnt vmcnt(2)" ::: "memory");
        __builtin_amdgcn_s_barrier(); asm volatile("" ::: "memory");
        AT_ISSUE(it + 3);
        const bool band = it < nbb;
        const int key0 = band ? blo + it * 32 : T + (it - nbb) * 32;
        if (band && (key0 < wlo || key0 >= whi)) continue;
        const LAS unsigned char* st = lds + (it & (AT_NS - 1)) * AT_STAGE;
        bf16x8 kf[2][2];
#pragma unroll
        for (int kt = 0; kt < 2; ++kt)
#pragma unroll
            for (int kk = 0; kk < 2; ++kk) { const int key = kt * 16 + fr, ch = kk * 4 + fq; kf[kt][kk] = *(const LAS bf16x8*)(st + key * 128 + ((ch ^ (key & 7)) << 4)); }
        bf16x8 vf[4];
#pragma unroll
        for (int dt = 0; dt < 4; ++dt) {
            const int row = dt * 16 + fr, sw = (row >> 2) & 3;
            const u32x2 lo = *(const LAS u32x2*)(st + 4096 + row * 64 + (((fq >> 1) ^ sw) << 4) + (fq & 1) * 8);
            const u32x2 hi = *(const LAS u32x2*)(st + 4096 + row * 64 + (((2 + (fq >> 1)) ^ sw) << 4) + (fq & 1) * 8);
            u32x4 w; w.x = lo.x; w.y = lo.y; w.z = hi.x; w.w = hi.y;
            vf[dt] = __builtin_bit_cast(bf16x8, w);
        }
        f32x4 sc[4][2];
#pragma unroll
        for (int qt = 0; qt < 4; ++qt) {
            f32x4 s0 = (f32x4){0.f, 0.f, 0.f, 0.f}, s1 = (f32x4){0.f, 0.f, 0.f, 0.f};
            s0 = __builtin_amdgcn_mfma_f32_16x16x32_bf16(kf[0][0], qf[qt][0], s0, 0, 0, 0);
            s0 = __builtin_amdgcn_mfma_f32_16x16x32_bf16(kf[0][1], qf[qt][1], s0, 0, 0, 0);
            s1 = __builtin_amdgcn_mfma_f32_16x16x32_bf16(kf[1][0], qf[qt][0], s1, 0, 0, 0);
            s1 = __builtin_amdgcn_mfma_f32_16x16x32_bf16(kf[1][1], qf[qt][1], s1, 0, 0, 0);
            sc[qt][0] = s0; sc[qt][1] = s1;
        }
        float mx[4];
#pragma unroll
        for (int qt = 0; qt < 4; ++qt)
            mx[qt] = fmaxf(fmaxf(fmaxf(sc[qt][0][0], sc[qt][0][1]), fmaxf(sc[qt][0][2], sc[qt][0][3])), fmaxf(fmaxf(sc[qt][1][0], sc[qt][1][1]), fmaxf(sc[qt][1][2], sc[qt][1][3])));
        const bool needmask = band && (key0 - q0 < -65 || key0 - q0 > 97);
        if (needmask) {
            const int dbase = key0 + fq * 4 - (q0 + fr);
#pragma unroll
            for (int qt = 0; qt < 4; ++qt) {
#pragma unroll
                for (int r = 0; r < 4; ++r) {
                    const int d0 = dbase + r - qt * 16, d1 = d0 + 16;
                    sc[qt][0][r] = (d0 > 128 || d0 < -128) ? -1e30f : sc[qt][0][r];
                    sc[qt][1][r] = (d1 > 128 || d1 < -128) ? -1e30f : sc[qt][1][r];
                }
                mx[qt] = fmaxf(fmaxf(fmaxf(sc[qt][0][0], sc[qt][0][1]), fmaxf(sc[qt][0][2], sc[qt][0][3])), fmaxf(fmaxf(sc[qt][1][0], sc[qt][1][1]), fmaxf(sc[qt][1][2], sc[qt][1][3])));
            }
        }
        float t16[4];
#pragma unroll
        for (int qt = 0; qt < 4; ++qt) t16[qt] = __shfl_xor(mx[qt], 16);
#pragma unroll
        for (int qt = 0; qt < 4; ++qt) mx[qt] = fmaxf(mx[qt], t16[qt]);
#pragma unroll
        for (int qt = 0; qt < 4; ++qt) t16[qt] = __shfl_xor(mx[qt], 32);
        float alpha[4]; bool resc = false;
#pragma unroll
        for (int qt = 0; qt < 4; ++qt) {
            mx[qt] = fmaxf(mx[qt], t16[qt]);
            const float mn = fmaxf(mrun[qt], mx[qt]);
            alpha[qt] = __builtin_amdgcn_exp2f(mrun[qt] - mn);
            resc = resc || (mn != mrun[qt]);
            mrun[qt] = mn;
        }
        bf16x8 pb[4];
#pragma unroll
        for (int qt = 0; qt < 4; ++qt) {
            float pr[8];
#pragma unroll
            for (int r = 0; r < 4; ++r) { pr[r] = __builtin_amdgcn_exp2f(sc[qt][0][r] - mrun[qt]); pr[4 + r] = __builtin_amdgcn_exp2f(sc[qt][1][r] - mrun[qt]); }
            lrun[qt] = lrun[qt] * alpha[qt] + ((pr[0] + pr[1]) + (pr[2] + pr[3])) + ((pr[4] + pr[5]) + (pr[6] + pr[7]));
            u32x4 pw; pw.x = cvt_pk_bf16(pr[0], pr[1]); pw.y = cvt_pk_bf16(pr[2], pr[3]); pw.z = cvt_pk_bf16(pr[4], pr[5]); pw.w = cvt_pk_bf16(pr[6], pr[7]);
            pb[qt] = __builtin_bit_cast(bf16x8, pw);
        }
        if (__any(resc)) {
#pragma unroll
            for (int qt = 0; qt < 4; ++qt)
#pragma unroll
                for (int dt = 0; dt < 4; ++dt) o[qt][dt] *= alpha[qt];
        }
#pragma unroll
        for (int qt = 0; qt < 4; ++qt)
#pragma unroll
            for (int dt = 0; dt < 4; ++dt) o[qt][dt] = __builtin_amdgcn_mfma_f32_16x16x32_bf16(vf[dt], pb[qt], o[qt][dt], 0, 0, 0);
    }
#undef AT_ISSUE
    const float sink = p.attn_sink[head];
#pragma unroll
    for (int qt = 0; qt < 4; ++qt) {
        float lt = lrun[qt]; lt += __shfl_xor(lt, 16); lt += __shfl_xor(lt, 32);
        lt += __builtin_amdgcn_exp2f(sink * 1.44269504f - mrun[qt]);
        const float inv = 1.0f / lt;
        bf16_t* dst = oatt + (size_t)(b * T + q0 + qt * 16 + fr) * 512 + head * 64 + fq * 4;
#pragma unroll
        for (int dt = 0; dt < 4; ++dt) { const f32x4 v = o[qt][dt] * inv; u32x2 w; w.x = cvt_pk_bf16(v[0], v[1]); w.y = cvt_pk_bf16(v[2], v[3]);
            *(u32x2*)(dst + dt * 16) = w; }
    }
    asm volatile("s_waitcnt vmcnt(0)" ::: "memory");
}

constexpr int LQS = 0, LQT = 17408, LKT = 34816, LST = 52224, LKDT = 87040, LVT = 105472, LPP = 123904, LCUM = 133120, LDEC = 135168, LROPE = 131072, LXST = 139264;
__device__ __forceinline__ void hgrn_unit(const Params& p, int unit, LAS unsigned char* lds, int tid) {
    const int dir = unit & 1, h = (unit >> 1) & 3, b = unit >> 3;
    const int wid = tid >> 6, lane = tid & 63, fr = lane & 15, fq = lane >> 4;
    const bf16_t* hbuf = (const bf16_t*)(p.ws + OFF_HBUF);
    bf16_t* odir = (bf16_t*)(p.ws + OFF_ODIR) + (size_t)dir * MLAT * 512;
    LAS bf16_t* Lqs = (LAS bf16_t*)(lds + LQS); LAS bf16_t* Lqt = (LAS bf16_t*)(lds + LQT); LAS bf16_t* Lkt = (LAS bf16_t*)(lds + LKT);
    LAS bf16_t* Lst = (LAS bf16_t*)(lds + LST); LAS bf16_t* Lkdt = (LAS bf16_t*)(lds + LKDT); LAS bf16_t* Lvt = (LAS bf16_t*)(lds + LVT);
    LAS bf16_t* Lp = (LAS bf16_t*)(lds + LPP); LAS float* Lcum = (LAS float*)(lds + LCUM); LAS float* Ldec = (LAS float*)(lds + LDEC);
    const int d = tid & 127, tg = tid >> 7;
    const float* lbraw = dir ? p.lb_bwd : p.lb_fwd;
    const float lbv = 1.0f / (1.0f + __expf(lbraw[512 + h * 128 + d] - lbraw[h * 128 + d]));
    const int colF = (dir ? 1024 : 512) + h * 128 + d, colQ = h * 128 + d, colV = 1536 + h * 128 + d;
    f32x4 Sacc[8];
#pragma unroll
    for (int ei = 0; ei < 8; ++ei) Sacc[ei] = (f32x4){0.f, 0.f, 0.f, 0.f};
#define LDSBAR() do { asm volatile("s_waitcnt lgkmcnt(0)" ::: "memory"); __builtin_amdgcn_s_barrier(); asm volatile("" ::: "memory"); } while (0)
    bf16_t pz[16], pq[16], pv[16];
#define HG_LOAD(cn) do { const bool latn_ = (cn) >= 4; const int ccn_ = latn_ ? (cn) - 4 : (cn); const int rbn_ = latn_ ? b * T : MLAT + b * L; const int sln_ = latn_ ? T - 1 : L - 1; \
        _Pragma("unroll") for (int i = 0; i < 16; ++i) { const int tl_ = ccn_ * 64 + tg * 16 + i, tok_ = dir ? sln_ - tl_ : tl_; const bf16_t* rp_ = hbuf + (size_t)(rbn_ + tok_) * 2048; pz[i] = rp_[colF]; pv[i] = rp_[colV]; if (latn_) pq[i] = rp_[colQ]; } } while (0)
#pragma unroll
    for (int i = 0; i < 16; ++i) pq[i] = 0;
    HG_LOAD(0);
#pragma unroll
    for (int ei = 0; ei < 8; ++ei) { u32x2 z; z.x = 0u; z.y = 0u; *(LAS u32x2*)(Lst + (ei * 16 + fr) * 136 + wid * 16 + fq * 4) = z; }
    LDSBAR();
    for (int c = 0; c < 36; ++c) {
        const bool lat = c >= 4;
        const int cc = lat ? c - 4 : c;
        const int rowbase = lat ? b * T : MLAT + b * L;
        const int seglast = lat ? T - 1 : L - 1;
        float gp[16], kk[16];
#pragma unroll
        for (int i = 0; i < 16; ++i) {
            const float z = bf2f(pz[i]);
            const float f = lbv + (1.0f - lbv) * sigmoidf_(z);
            gp[i] = f; kk[i] = 1.0f - f;
        }
        { float run = gp[15];
#pragma unroll
          for (int i = 14; i >= 0; --i) { kk[i] *= run; run *= gp[i]; } }
#pragma unroll
        for (int i = 1; i < 16; ++i) gp[i] *= gp[i - 1];
        Lcum[tg * 128 + d] = __logf(gp[15]);
        LDSBAR();
        const float c0 = Lcum[d], c1 = Lcum[128 + d], c2 = Lcum[256 + d], c3 = Lcum[384 + d];
        const float off = tg == 0 ? 0.f : tg == 1 ? c0 : tg == 2 ? c0 + c1 : c0 + c1 + c2;
        const float mid = c0 + c1, tot = (c0 + c1) + (c2 + c3);
        const float e_off = __expf(off), e_om = __expf(off - mid), e_mo = __expf(mid - off), e_to = __expf(tot - off);
        const float rgl = __builtin_amdgcn_rcpf(gp[15]);
#define rg kk
#pragma unroll
        for (int i = 0; i < 16; ++i) kk[i] *= rgl;
        if (lat) {
#pragma unroll
            for (int i = 0; i < 16; ++i) {
                const int t = tg * 16 + i;
                const float qg = bf2f(pq[i]) * gp[i];
                Lqs[t * 136 + d] = f2bf(qg * e_off);
                Lqt[t * 136 + d] = f2bf(qg * e_om);
                Lkt[t * 136 + d] = f2bf(rg[i] * e_mo);
            }
        }
        {
            u32x4 w0, w1;
            w0.x = cvt_pk_bf16(rg[0] * e_to, rg[1] * e_to); w0.y = cvt_pk_bf16(rg[2] * e_to, rg[3] * e_to); w0.z = cvt_pk_bf16(rg[4] * e_to, rg[5] * e_to); w0.w = cvt_pk_bf16(rg[6] * e_to, rg[7] * e_to);
            w1.x = cvt_pk_bf16(rg[8] * e_to, rg[9] * e_to); w1.y = cvt_pk_bf16(rg[10] * e_to, rg[11] * e_to); w1.z = cvt_pk_bf16(rg[12] * e_to, rg[13] * e_to); w1.w = cvt_pk_bf16(rg[14] * e_to, rg[15] * e_to);
            *(LAS u32x4*)(Lkdt + d * 72 + tg * 16) = w0; *(LAS u32x4*)(Lkdt + d * 72 + tg * 16 + 8) = w1;
            if (tg == 0) Ldec[d] = __expf(tot);
        }
        {
            u32x4 w0, w1;
            w0.x = pv[0] | ((unsigned)pv[1] << 16); w0.y = pv[2] | ((unsigned)pv[3] << 16); w0.z = pv[4] | ((unsigned)pv[5] << 16); w0.w = pv[6] | ((unsigned)pv[7] << 16);
            w1.x = pv[8] | ((unsigned)pv[9] << 16); w1.y = pv[10] | ((unsigned)pv[11] << 16); w1.z = pv[12] | ((unsigned)pv[13] << 16); w1.w = pv[14] | ((unsigned)pv[15] << 16);
            *(LAS u32x4*)(Lvt + d * 72 + tg * 16) = w0; *(LAS u32x4*)(Lvt + d * 72 + tg * 16 + 8) = w1;
        }
        if (c + 1 < 36) HG_LOAD(c + 1);
        LDSBAR();
        if (lat) {
            const int ti = wid >> 1;
#pragma unroll
            for (int uu = 0; uu < 2; ++uu) {
                const int si = (wid & 1) * 2 + uu;
                f32x4 a = (f32x4){0.f, 0.f, 0.f, 0.f};
#pragma unroll
                for (int k4 = 0; k4 < 4; ++k4) {
                    const bf16x8 af = *(const LAS bf16x8*)(Lqt + (ti * 16 + fr) * 136 + k4 * 32 + fq * 8);
                    const bf16x8 bf = *(const LAS bf16x8*)(Lkt + (si * 16 + fr) * 136 + k4 * 32 + fq * 8);
                    a = __builtin_amdgcn_mfma_f32_16x16x32_bf16(af, bf, a, 0, 0, 0);
                }
                const int s = si * 16 + fr;
#pragma unroll
                for (int r = 0; r < 4; ++r) { const int t = ti * 16 + fq * 4 + r; const float v = (si <= ti && s <= t) ? a[r] : 0.f; Lp[t * 72 + s] = f2bf(v); }
            }
            LDSBAR();
#pragma unroll
            for (int uu = 0; uu < 4; ++uu) {
                const int ei = (wid & 1) * 4 + uu;
                f32x4 a = (f32x4){0.f, 0.f, 0.f, 0.f};
#pragma unroll
                for (int k4 = 0; k4 < 4; ++k4) {
                    const bf16x8 af = *(const LAS bf16x8*)(Lqs + (ti * 16 + fr) * 136 + k4 * 32 + fq * 8);
                    const bf16x8 bf = *(const LAS bf16x8*)(Lst + (ei * 16 + fr) * 136 + k4 * 32 + fq * 8);
                    a = __builtin_amdgcn_mfma_f32_16x16x32_bf16(af, bf, a, 0, 0, 0);
                }
#pragma unroll
                for (int k2 = 0; k2 < 2; ++k2) {
                    const bf16x8 af = *(const LAS bf16x8*)(Lp + (ti * 16 + fr) * 72 + k2 * 32 + fq * 8);
                    const bf16x8 bf = *(const LAS bf16x8*)(Lvt + (ei * 16 + fr) * 72 + k2 * 32 + fq * 8);
                    a = __builtin_amdgcn_mfma_f32_16x16x32_bf16(af, bf, a, 0, 0, 0);
                }
#pragma unroll
                for (int r = 0; r < 4; ++r) {
                    const int tl = cc * 64 + ti * 16 + fq * 4 + r, tok = dir ? seglast - tl : tl;
                    odir[(size_t)(rowbase + tok) * 512 + h * 128 + ei * 16 + fr] = f2bf(a[r]);
                }
            }
        }
        {
            const f32x4 dec = *(const LAS f32x4*)(Ldec + wid * 16 + fq * 4);
#pragma unroll
            for (int ei = 0; ei < 8; ++ei) {
                f32x4 a = Sacc[ei] * dec;
#pragma unroll
                for (int k2 = 0; k2 < 2; ++k2) {
                    const bf16x8 af = *(const LAS bf16x8*)(Lkdt + (wid * 16 + fr) * 72 + k2 * 32 + fq * 8);
                    const bf16x8 bf = *(const LAS bf16x8*)(Lvt + (ei * 16 + fr) * 72 + k2 * 32 + fq * 8);
                    a = __builtin_amdgcn_mfma_f32_16x16x32_bf16(af, bf, a, 0, 0, 0);
                }
                Sacc[ei] = a;
            }
        }
        LDSBAR();
#pragma unroll
        for (int ei = 0; ei < 8; ++ei) { u32x2 w; w.x = cvt_pk_bf16(Sacc[ei][0], Sacc[ei][1]); w.y = cvt_pk_bf16(Sacc[ei][2], Sacc[ei][3]);
            *(LAS u32x2*)(Lst + (ei * 16 + fr) * 136 + wid * 16 + fq * 4) = w; }
    }
    __syncthreads();
#undef HG_LOAD
#undef rg
}

#define XB_TMO      128
#define XB_XCNT(j)  (256  + 64 * (j))
#define XB_XSUB(j)  (1280 + 64 * (j))
#define XB_XGEN(j)  (2304 + 64 * (j))
#define XB_TOP      3328
#define XB_TOPGEN   3392
#define XCD_BAR_WORDS 3456
#define XB_SPIN_CAP (1u << 20)
__device__ __forceinline__ unsigned xb_ld(unsigned* p)              { return __hip_atomic_load(p, __ATOMIC_RELAXED, __HIP_MEMORY_SCOPE_AGENT); }
__device__ __forceinline__ unsigned xb_add(unsigned* p, unsigned v) { return __hip_atomic_fetch_add(p, v, __ATOMIC_RELAXED, __HIP_MEMORY_SCOPE_AGENT); }
__device__ __forceinline__ unsigned xb_xcc_id() { return (unsigned)__builtin_amdgcn_s_getreg((3 << 11) | 20) & 0xFu; }
#define XB_SPIN(cond, bar) do { unsigned _sp = 0; while (cond) { __builtin_amdgcn_s_sleep(1); \
    if ((++_sp & 255u) == 0u) { if (xb_ld(&(bar)[XB_TMO])) break; if (_sp > XB_SPIN_CAP) { atomicAdd(&(bar)[XB_TMO], 1u); break; } } } } while (0)
__device__ __forceinline__ void xcd_barrier_complete(unsigned* bar, unsigned x, unsigned& nloc, unsigned& nx) {
    const unsigned G = gridDim.x * gridDim.y * gridDim.z;
    unsigned sum, cnt, mine, sp = 0u;
    for (;;) {
        sum = 0u; cnt = 0u; mine = 0u;
#pragma unroll
        for (unsigned j = 0; j < 16; ++j) { const unsigned c = xb_ld(&bar[XB_XCNT(j)]); sum += c; cnt += (c > 0u) ? 1u : 0u; mine = (j == x) ? c : mine; }
        if (sum == G) break;
        __builtin_amdgcn_s_sleep(1);
        if ((++sp & 255u) == 0u) { if (xb_ld(&bar[XB_TMO])) break; if (sp > XB_SPIN_CAP) { atomicAdd(&bar[XB_TMO], 1u); break; } }
    }
    nloc = mine > 0u ? mine : 1u; nx = cnt > 0u ? cnt : 1u;
}
__device__ __forceinline__ void xcd_barrier(unsigned* bar, volatile LAS unsigned* st) {
    asm volatile("s_waitcnt vmcnt(0)" ::: "memory");
    __syncthreads();
    if (threadIdx.x == 0) {
        const unsigned x = xb_xcc_id();
        __builtin_amdgcn_s_waitcnt(0);
        unsigned nloc = st[0], nx = st[1];
        if (nloc == 0u) { xcd_barrier_complete(bar, x, nloc, nx); st[0] = nloc; st[1] = nx; }
        const unsigned old = xb_add(&bar[XB_XSUB(x)], 1u);
        const unsigned gen = old / nloc;
        if (old + 1u == (gen + 1u) * nloc) {
            __builtin_amdgcn_fence(__ATOMIC_RELEASE, "agent");
            asm volatile("s_waitcnt vmcnt(0)" ::: "memory");
            const unsigned og = xb_add(&bar[XB_TOP], 1u);
            const unsigned tg = og / nx;
            if (og + 1u == (tg + 1u) * nx) xb_add(&bar[XB_TOPGEN], 1u);
            else XB_SPIN(xb_ld(&bar[XB_TOPGEN]) == tg, bar);
            __builtin_amdgcn_fence(__ATOMIC_ACQUIRE, "agent");
            xb_add(&bar[XB_XGEN(x)], 1u);
            asm volatile("s_waitcnt vmcnt(0)" ::: "memory");
        } else {
            XB_SPIN(xb_ld(&bar[XB_XGEN(x)]) == gen, bar);
            __builtin_amdgcn_fence(__ATOMIC_ACQUIRE, "agent");
            asm volatile("s_waitcnt vmcnt(0)" ::: "memory");
        }
    }
    __syncthreads();
}

__global__ void __launch_bounds__(512, 2) mega(Params p, int ph_lo, int ph_hi) {
    extern __shared__ __attribute__((aligned(16))) unsigned char shm[];
    LAS unsigned char* lds = (LAS unsigned char*)shm;
    volatile LAS unsigned* xst = (volatile LAS unsigned*)(lds + LXST);
    unsigned* xbar = (unsigned*)(p.ws + OFF_BAR);
    if (threadIdx.x == 0) { xst[0] = 0u; xst[1] = 0u; }
    __syncthreads();
    if (ph_hi - ph_lo > 1 && threadIdx.x == 0) (void)xb_add(&xbar[XB_XCNT(xb_xcc_id())], 1u);
#ifndef PROBE_PH
#define PROBE_PH -1
#define PROBE_EXTRA 0
#endif
    for (int phi = ph_lo; phi < ph_hi + PROBE_EXTRA; ++phi) {
        const int ph = (PROBE_PH < 0 || phi <= PROBE_PH) ? phi : (phi <= PROBE_PH + PROBE_EXTRA ? PROBE_PH : phi - PROBE_EXTRA);
        int tid = threadIdx.x; asm volatile("" : "+v"(tid));
        int G = gridDim.x, c = blockIdx.x; asm volatile("" : "+s"(G), "+s"(c));
        unsigned char* ws = p.ws;
        const int wid = tid >> 6, lane = tid & 63;
        const float* mod = (const float*)(ws + OFF_MOD);
        switch (ph) {
        case 0: if (PH_ON(0)) {
            for (int it = c; it < 288 + 1; it += G) {
                if (it < 288) mod_partial_item(p, it, (LAS float*)lds, tid);
                else { for (int i = tid; i < 1024; i += 512) { const int pos = i >> 4, fi = i & 15; const float fr_ = powf(10000.0f, -(float)fi / 16.0f), ang = (float)pos * fr_;
                        ((float2*)(ws + OFF_ROPE))[i] = make_float2(cosf(ang), sinf(ang)); } }
            }
            __syncthreads();
            convert_tiles(p, ws, 0, 3968, c, G, (LAS float*)lds, tid);
        } break;
        case 1: if (PH_ON(1)) {
            const float* part = (const float*)(ws + OFF_PART);
            for (int i = c * 512 + tid; i < 17 * NMOD * D; i += G * 512) {
                const int n = i % (NMOD * D);
                float s = p.b_ada[n];
#pragma unroll
                for (int ks = 0; ks < 16; ++ks) s += part[(size_t)ks * 17 * NMOD * D + i];
                ((float*)(ws + OFF_MOD))[i] = s;
            }
        } break;
        case 2: if (PH_ON(2)) {
            const int gw = c * 8 + wid, rpw = MALL / (G * 8);
            rows_phase<false, true, false, 0>(mod, gw * rpw, gw * rpw + rpw, p.x, p.ctx, (const bf16_t*)p.out, (const bf16_t*)(ws + OFF_Y), 0.f, 0, p.norm_post, p.out, p.norm_pre, 0, (bf16_t*)(ws + OFF_HA), lane);
        } break;
        case 3: case 13: if (PH_ON(3)) {
            const bool second = ph == 13;
            RectOrder S; S.A = (const char*)(ws + OFF_HA); S.B = (const char*)(ws + OFF_WFFN_IN); S.K = D; S.nM = second ? 128 : 144; S.nN = 22; S.nwg = S.nM * S.nN; S.G = G; S.c = c; S.pm0 = 0;
            EpiSwiglu E; E.act = (bf16_t*)(ws + OFF_ACT);
            gemm_phase(lds, D, S, E, tid);
        } break;
        case 4: case 5: case 11: case 14: if (PH_ON(4)) {
            RectOrder S; S.G = G; S.c = c; S.nN = 4; S.pm0 = 0; int K; bool dogemm = true;
            if (ph == 11) { S.A = (const char*)(ws + OFF_U); S.B = (const char*)(ws + OFF_WOUT); K = D; S.nM = 128; }
            else { S.A = (const char*)(ws + OFF_ACT); S.B = (const char*)(ws + OFF_WFFN_OUT); K = DFF; S.nM = 128; }
            if (ph == 5) {
                if (c >= 64) {
                    dogemm = false;
                    const int nw = (G - 64) * 8, gw = (c - 64) * 8 + wid, rpw = (MLAT + nw - 1) / nw;
                    const int r0 = gw * rpw, r1 = r0 + rpw < MLAT ? r0 + rpw : MLAT;
                    if (r0 < MLAT) rows_phase<true, true, false, 1>(mod, r0, r1, p.x, p.ctx, (const bf16_t*)p.out, (const bf16_t*)(ws + OFF_Y), 0.5f, 2, p.norm_post, p.out, p.norm_pre + D, 3, (bf16_t*)(ws + OFF_HA), lane);
                } else { S.nM = 16; S.pm0 = 128; S.G = 64; }
            }
            S.K = K; S.nwg = S.nM * S.nN;
            if (dogemm) {
                EpiBf16 E; E.C = (bf16_t*)(ws + OFF_Y); E.ldc = D;
                gemm_phase(lds, K, S, E, tid);
            }
        } break;
        case 6: if (PH_ON(5)) {
            const int gw = c * 8 + wid, rpw = MCTX / (G * 8);
            rows_phase<true, true, false, 0>(mod, MLAT + gw * rpw, MLAT + gw * rpw + rpw, p.x, p.ctx, (const bf16_t*)p.out, (const bf16_t*)(ws + OFF_Y), 0.5f, 2, p.norm_post, p.out, p.norm_pre + D, 3, (bf16_t*)(ws + OFF_HA), lane);
        } break;
        case 7: if (PH_ON(6)) {
            MixOrder S; S.A = (const char*)(ws + OFF_HA); S.B = (const char*)(ws + OFF_WMIX); S.G = G; S.c = c;
            EpiMixIn E; E.qbuf = (bf16_t*)(ws + OFF_QBUF); E.kall = (bf16_t*)(ws + OFF_KALL); E.vt = (bf16_t*)(ws + OFF_VT); E.hbuf = (bf16_t*)(ws + OFF_HBUF); E.gbuf = (bf16_t*)(ws + OFF_GBUF);
            ((LAS f32x4*)(lds + 131072))[tid] = ((const f32x4*)(ws + OFF_ROPE))[tid];
            __syncthreads();
            E.rope = (const LAS float2*)(lds + 131072);
            gemm_phase(lds, D, S, E, tid);
        } break;
        case 8: if (PH_ON(7)) {
            const int half = G >> 1;
#ifndef REP_HGRN
#define REP_HGRN 1
#define REP_ATTN 1
#endif
            if (c < half) { for (int rep = 0; rep < REP_HGRN; ++rep) for (int it = c; it < 128; it += half) hgrn_unit(p, it, lds, tid); }
            else { int tid2 = tid; asm volatile("" : "+v"(tid2));
                for (int rep = 0; rep < REP_ATTN; ++rep) for (int it = c - half; it < 512; it += G - half) attn_item(p, it, tid2, lds);
                __syncthreads();
                convert_tiles(p, ws, 1, 2112, c - half, G - half, (LAS float*)lds, tid);
            }
        } break;
        case 9: if (PH_ON(8)) {
            const bf16_t* of = (const bf16_t*)(ws + OFF_ODIR); const bf16_t* ob = of + (size_t)MLAT * 512;
            const bf16_t* gb = (const bf16_t*)(ws + OFF_GBUF); bf16_t* orr = (bf16_t*)(ws + OFF_OR);
            for (int r = c * 8 + wid; r < MLAT; r += G * 8) {
                const u32x4 a = *(const u32x4*)(of + (size_t)r * 512 + lane * 8), bq = *(const u32x4*)(ob + (size_t)r * 512 + lane * 8);
                const u32x4 gq = *(const u32x4*)(gb + (size_t)r * 2560 + lane * 8);
                float v[8]; float ss = 0.f;
#pragma unroll
                for (int q = 0; q < 4; ++q) { v[q * 2] = bflo(a[q]) + bflo(bq[q]); v[q * 2 + 1] = bfhi(a[q]) + bfhi(bq[q]); ss += v[q * 2] * v[q * 2] + v[q * 2 + 1] * v[q * 2 + 1]; }
                ss = wave_sum(ss);
                const float rstd = rsqrtf(ss * (1.0f / 512.0f) + EPS);
                const f32x4 g0 = *(const f32x4*)(p.hgrn_norm + lane * 8), g1 = *(const f32x4*)(p.hgrn_norm + lane * 8 + 4);
                float o[8];
#pragma unroll
                for (int q = 0; q < 4; ++q) {
                    const float h0 = bflo(gq[q]), h1 = bfhi(gq[q]);
                    const float gg0 = q < 2 ? g0[q * 2] : g1[q * 2 - 4], gg1 = q < 2 ? g0[q * 2 + 1] : g1[q * 2 - 3];
                    o[q * 2] = v[q * 2] * rstd * gg0 * siluf_(h0); o[q * 2 + 1] = v[q * 2 + 1] * rstd * gg1 * siluf_(h1);
                }
                u32x4 w; w.x = cvt_pk_bf16(o[0], o[1]); w.y = cvt_pk_bf16(o[2], o[3]); w.z = cvt_pk_bf16(o[4], o[5]); w.w = cvt_pk_bf16(o[6], o[7]);
                *(u32x4*)(orr + (size_t)r * 512 + lane * 8) = w;
            }
            __syncthreads();
        } break;
        case 10: if (PH_ON(9)) {
            MergeOrder S; S.A0 = (const char*)(ws + OFF_OATT); S.B0 = (const char*)(ws + OFF_WOA); S.A1 = (const char*)(ws + OFF_OR); S.B1 = (const char*)(ws + OFF_WOH); S.G = G; S.c = c;
            EpiMerge E; E.gbuf = (const bf16_t*)(ws + OFF_GBUF); E.U = (bf16_t*)(ws + OFF_U);
            gemm_phase(lds, 512, S, E, tid);
        } break;
        case 12: if (PH_ON(11)) {
            const int gw = c * 8 + wid, rpw = MLAT / (G * 8);
            rows_phase<true, true, true, 1>(mod, gw * rpw, gw * rpw + rpw, p.x, p.ctx, (const bf16_t*)p.out, (const bf16_t*)(ws + OFF_Y), 1.0f, 5, p.norm_post + D, ws + OFF_X2, p.norm_pre + 2 * D, 6, (bf16_t*)(ws + OFF_HA), lane);
        } break;
        case 15: if (PH_ON(14)) {
            const int gw = c * 8 + wid, rpw = MLAT / (G * 8);
            rows_phase<true, false, true, 2>(mod, gw * rpw, gw * rpw + rpw, p.x, p.ctx, (const bf16_t*)(ws + OFF_X2), (const bf16_t*)(ws + OFF_Y), 0.5f, 8, p.norm_post + 2 * D, p.out, p.norm_pre, 0, (bf16_t*)(ws + OFF_HA), lane);
        } break;
        default: break;
        }
        if (phi + 1 < ph_hi + PROBE_EXTRA) xcd_barrier(xbar, xst);
    }
}

extern "C" void kernel_launch(void* const* d_in, const int* in_sizes, int n_in, void* d_out, int out_size, void* d_ws, size_t ws_size, hipStream_t stream) {
    static int grid_blocks = 0;
    if (!grid_blocks) {
        hipFuncSetAttribute((const void*)mega, hipFuncAttributeMaxDynamicSharedMemorySize, LDS_BYTES);
        int dev = 0, cus = 0, per_cu = 0;
        hipGetDevice(&dev);
        hipDeviceGetAttribute(&cus, hipDeviceAttributeMultiprocessorCount, dev);
        hipOccupancyMaxActiveBlocksPerMultiprocessor(&per_cu, mega, 512, LDS_BYTES);
        if (per_cu < 1) per_cu = 1;
        if (per_cu > 1) per_cu = 1;
        grid_blocks = cus * per_cu;
        if (grid_blocks > 256) grid_blocks = 256;
    }
    Params p{};
    const float** pp = (const float**)&p;
    for (int i = 0; i < 20; ++i) pp[i] = (const float*)d_in[i];
    p.out = (float*)d_out; p.ws = (unsigned char*)d_ws;
    hipMemsetAsync((unsigned char*)d_ws + OFF_BAR, 0, XCD_BAR_WORDS * sizeof(unsigned), stream);
#if MULTI_LAUNCH
    for (int ph = 0; ph < NPH; ++ph) { hipLaunchKernelGGL(mega, dim3(grid_blocks), dim3(512), LDS_BYTES, stream, p, ph, ph + 1); }
#else
    hipLaunchKernelGGL(mega, dim3(grid_blocks), dim3(512), LDS_BYTES, stream, p, 0, NPH);
#endif
}
```
